# Optimizing an MI355X kernel written in HIP

```python
import jax, jax.numpy as jnp
from jax import lax
import numpy as np

D_MODEL = 1024
BATCH = 16
SEQ = 256
DEPTH = 1
DEC_BATCH = 8
DEC_SEQ = 2048
PAST_LEN = 256

GRID_W = 64
D_MIX = D_MODEL
D_A = D_MIX // 2
HEAD_A = 64
H_A = D_A // HEAD_A
LORA_W = 64
LORA_A = 64
D_B = D_MIX - D_A
HG_EXPAND = 128
H_B = D_B // HG_EXPAND
DV_B = D_B // H_B
CHUNK = 64
N_DIR = 2
EPS = 1e-6
GN_EPS = 64e-5
A_COLS = 4 * D_A + N_DIR * (LORA_W + LORA_A)
B_COLS = 5 * D_B
IN_COLS = A_COLS + B_COLS

kernel_name = 'hybrid_rwkv7_hgrn2_diffusion_step'


def rmsnorm(x, g):
    x32 = x.astype(jnp.float32)
    y = x32 * lax.rsqrt(jnp.mean(x32 * x32, axis=-1, keepdims=True) + EPS)
    return y.astype(x.dtype) * g


def modulation(cvec, w_ada, b_ada):
    m = (jax.nn.silu(cvec) @ w_ada + b_ada)[:, None, :]
    shift, scale, gate = jnp.split(m, 3, axis=-1)
    return shift, scale, gate


def _neighbour_mean(p, axis):
    n = p.shape[axis]
    pad = [(0, 0)] * p.ndim
    pad[axis] = (1, 1)
    pp = jnp.pad(p, pad)
    prev = lax.slice_in_dim(pp, 0, n, axis=axis)
    nxt = lax.slice_in_dim(pp, 2, n + 2, axis=axis)
    return 0.5 * (prev + nxt)


def token_shift(p, mu_h, mu_v, grid):
    if grid:
        B, T, C = p.shape
        rows = T // GRID_W
        pg = p.reshape(B, rows, GRID_W, C)
        h = _neighbour_mean(pg, 2).reshape(B, T, C)
        v = _neighbour_mean(pg, 1).reshape(B, T, C)
        return p + mu_h * (h - p) + mu_v * (v - p)
    h = _neighbour_mean(p, 1)
    return p + mu_h * (h - p)


def _flip(z):
    return jnp.flip(z, axis=1)


def rwkv7_scan(r, w, k, v, kk, a, s0):
    def step(S, inp):
        r_t, w_t, k_t, v_t, kk_t, a_t = inp
        sa = jnp.einsum('bhvk,bhk->bhv', S, kk_t)
        S = (S * w_t[:, :, None, :]
             - sa[..., None] * (kk_t * a_t)[:, :, None, :]
             + v_t[..., None] * k_t[:, :, None, :])
        y = jnp.einsum('bhvk,bhk->bhv', S, r_t)
        return S, y
    xs = tuple(jnp.moveaxis(z, 1, 0) for z in (r, w, k, v, kk, a))
    S, ys = lax.scan(step, s0, xs)
    return jnp.moveaxis(ys, 0, 1), S


def hgrn2_chunk(q, k, v, logf, s0):
    B, T, H, K = q.shape
    V = v.shape[-1]
    nc = T // CHUNK

    def to_chunks(z):
        return jnp.moveaxis(z.reshape(B, nc, CHUNK, H, z.shape[-1]), 1, 0)

    causal = jnp.tril(jnp.ones((CHUNK, CHUNK), dtype=bool))[None, :, :, None, None]

    def step(S, inp):
        qc, kc, vc, gc = inp
        G = jnp.cumsum(gc, axis=1)
        o_inter = jnp.einsum('bthk,bhkv->bthv', qc * jnp.exp(G), S)
        diff = G[:, :, None] - G[:, None, :]
        decay = jnp.exp(jnp.where(causal, diff, -jnp.inf))
        A = jnp.einsum('bthk,btshk->bhts', qc, decay * kc[:, None])
        o = o_inter + jnp.einsum('bhts,bshv->bthv', A, vc)
        G_last = G[:, -1]
        k_dec = kc * jnp.exp(G_last[:, None] - G)
        S = S * jnp.exp(G_last)[..., None] + jnp.einsum('bchk,bchv->bhkv', k_dec, vc)
        return S, o

    S, o = lax.scan(step, s0, tuple(to_chunks(z) for z in (q, k, v, logf)))
    o = jnp.moveaxis(o, 0, 1).reshape(B, T, H, V)
    return o, S


def layer_mix(xm, s_a0, s_b0, grid, w_in, mu_h, mu_v, w0, w2, a0, a2, k_k, k_a, r_k,
              lnx_w, lnx_b, lb, onorm_g, w_out):
    B, T, _ = xm.shape
    dt = xm.dtype
    f32 = jnp.float32
    p = xm @ w_in
    pa = token_shift(p[..., :A_COLS], mu_h, mu_v, grid)
    pb = p[..., A_COLS:]

    r, k, v, za = jnp.split(pa[..., :4 * D_A], 4, axis=-1)
    lora = pa[..., 4 * D_A:].reshape(B, T, N_DIR, LORA_W + LORA_A)
    w_log = (w0 + jnp.einsum('btdr,drc->btdc', jnp.tanh(lora[..., :LORA_W]), w2)).astype(f32)
    decay = jnp.exp(-jnp.exp(-jax.nn.softplus(-w_log) - 0.5))
    a = jax.nn.sigmoid((a0 + jnp.einsum('btdr,drc->btdc', lora[..., LORA_W:], a2)).astype(f32))
    hA = lambda z: z.reshape(B, T, H_A, HEAD_A)
    kk = hA((k * k_k).astype(f32))
    kk = kk / jnp.maximum(jnp.linalg.norm(kk, axis=-1, keepdims=True), 1e-12)
    k_eff = k.astype(f32)[:, :, None] * (1.0 + (a - 1.0) * k_a.astype(f32))
    rf, vf = hA(r.astype(f32)), hA(v.astype(f32))
    y_f, sa_f = rwkv7_scan(rf, hA(decay[:, :, 0]), hA(k_eff[:, :, 0]), vf, kk, hA(a[:, :, 0]),
                           s_a0[:, 0].astype(f32))
    y_b, sa_b = rwkv7_scan(_flip(rf), _flip(hA(decay[:, :, 1])), _flip(hA(k_eff[:, :, 1])), _flip(vf),
                           _flip(kk), _flip(hA(a[:, :, 1])), s_a0[:, 1].astype(f32))
    y = y_f + _flip(y_b)
    mu = jnp.mean(y, axis=-1, keepdims=True)
    var = jnp.mean(jnp.square(y - mu), axis=-1, keepdims=True)
    y = ((y - mu) * lax.rsqrt(var + GN_EPS)).reshape(B, T, D_A) * lnx_w + lnx_b
    bonus = jnp.sum(rf * hA(jnp.mean(k_eff, axis=2)) * r_k, axis=-1, keepdims=True) * vf
    out_a = (y + bonus.reshape(B, T, D_A)).astype(dt) * jax.nn.silu(za)

    hB = lambda z: z.reshape(B, T, H_B, HG_EXPAND)
    q = hB(jax.nn.silu(pb[..., :D_B]).astype(f32))
    vb = pb[..., D_B:2 * D_B].astype(f32).reshape(B, T, H_B, DV_B)
    f = lb + (1.0 - lb) * jax.nn.sigmoid(pb[..., 2 * D_B:4 * D_B].reshape(B, T, N_DIR, D_B).astype(f32))
    zb = pb[..., 4 * D_B:]
    kf, gf = 1.0 - f, jnp.log(f)
    o_f, sb_f = hgrn2_chunk(q, hB(kf[:, :, 0]), vb, hB(gf[:, :, 0]), s_b0[:, 0].astype(f32))
    o_b, sb_b = hgrn2_chunk(_flip(q), _flip(hB(kf[:, :, 1])), _flip(vb), _flip(hB(gf[:, :, 1])),
                            s_b0[:, 1].astype(f32))
    o = o_f + _flip(o_b)
    o = (o * lax.rsqrt(jnp.mean(o * o, axis=-1, keepdims=True) + EPS)).reshape(B, T, D_B) * onorm_g
    out_b = o.astype(dt) * jax.nn.silu(zb)

    out = jnp.concatenate([out_a, out_b], axis=-1) @ w_out
    s_a = jnp.stack([sa_f, sa_b], axis=1)
    s_b = jnp.stack([sb_f, sb_b], axis=1)
    return out, s_a, s_b


def setup_inputs(seed: int = 0) -> dict:
    key = jax.random.key(seed)
    ks = jax.random.split(key, 28)
    n = lambda i, shape: jax.random.normal(ks[i], shape, jnp.float32)
    u = lambda i, shape, lo, hi: jax.random.uniform(ks[i], shape, jnp.float32, lo, hi)
    return {
        'x_prompt': n(0, (BATCH, SEQ, D_MODEL)),
        'x_sample': n(1, (DEC_BATCH, DEC_SEQ, D_MODEL)),
        'state_rwkv': 0.3 * n(2, (DEC_BATCH, DEPTH, N_DIR, H_A, HEAD_A, HEAD_A)),
        'state_hgrn': 0.3 * n(3, (DEC_BATCH, DEPTH, N_DIR, H_B, HG_EXPAND, DV_B)),
        'c': n(4, (DEC_BATCH, D_MODEL)),
        'c_ctx': n(5, (D_MODEL,)),
        'norm_g': 1.0 + 0.02 * n(6, (DEPTH, D_MODEL)),
        'w_ada': 0.5 * D_MODEL ** -0.5 * n(7, (DEPTH, D_MODEL, 3 * D_MODEL)),
        'b_ada': 0.01 * n(8, (DEPTH, 3 * D_MODEL)),
        'w_in': D_MODEL ** -0.5 * n(9, (DEPTH, D_MODEL, IN_COLS)),
        'mu_h': u(10, (DEPTH, A_COLS), 0.0, 0.6),
        'mu_v': u(11, (DEPTH, A_COLS), 0.0, 0.6),
        'w0': u(12, (DEPTH, N_DIR, D_A), -4.0, 1.0),
        'w2': 0.5 * LORA_W ** -0.5 * n(13, (DEPTH, N_DIR, LORA_W, D_A)),
        'a0': 0.5 * n(14, (DEPTH, N_DIR, D_A)),
        'a2': 0.5 * LORA_A ** -0.5 * n(15, (DEPTH, N_DIR, LORA_A, D_A)),
        'k_k': 0.85 + 0.05 * n(16, (DEPTH, D_A)),
        'k_a': 1.0 + 0.05 * n(17, (DEPTH, D_A)),
        'r_k': 0.1 * n(18, (DEPTH, H_A, HEAD_A)),
        'lnx_w': 1.0 + 0.02 * n(19, (DEPTH, D_A)),
        'lnx_b': 0.01 * n(20, (DEPTH, D_A)),
        'lb_logits': 0.1 * n(21, (DEPTH + 1, N_DIR, D_B)),
        'onorm_g': 1.0 + 0.02 * n(22, (DEPTH, D_B)),
        'w_out': D_MIX ** -0.5 * n(23, (DEPTH, D_MIX, D_MODEL)),
        'final_g': 1.0 + 0.02 * n(24, (D_MODEL,)),
    }


def reference(x_prompt, x_sample, state_rwkv, state_hgrn, c, c_ctx, norm_g, w_ada, b_ada, w_in,
              mu_h, mu_v, w0, w2, a0, a2, k_k, k_a, r_k, lnx_w, lnx_b, lb_logits, onorm_g,
              w_out, final_g):
    lb_all = jnp.cumsum(jax.nn.softmax(lb_logits.astype(jnp.float32), axis=0), axis=0)
    hp, hs = x_prompt, x_sample
    Bp = x_prompt.shape[0]
    new_a, new_b = [], []
    for l in range(DEPTH):
        params = (w_in[l], mu_h[l], mu_v[l], w0[l], w2[l], a0[l], a2[l], k_k[l], k_a[l], r_k[l],
                  lnx_w[l], lnx_b[l], lb_all[l], onorm_g[l], w_out[l])
        zero_a = jnp.zeros((Bp, N_DIR, H_A, HEAD_A, HEAD_A), jnp.float32)
        zero_b = jnp.zeros((Bp, N_DIR, H_B, HG_EXPAND, DV_B), jnp.float32)
        sh, sc, g = modulation(c_ctx[None, :], w_ada[l], b_ada[l])
        xm = rmsnorm(hp, norm_g[l]) * (1.0 + sc) + sh
        out, s_a, s_b = layer_mix(xm, zero_a, zero_b, False, *params)
        hp = hp + g * out
        new_a.append(s_a.astype(x_prompt.dtype))
        new_b.append(s_b.astype(x_prompt.dtype))
        sh, sc, g = modulation(c, w_ada[l], b_ada[l])
        xm = rmsnorm(hs, norm_g[l]) * (1.0 + sc) + sh
        out, _, _ = layer_mix(xm, state_rwkv[:, l], state_hgrn[:, l], True, *params)
        hs = hs + g * out
    y_prompt = rmsnorm(hp, final_g)
    y_sample = rmsnorm(hs, final_g)
    new_state_rwkv = jnp.stack(new_a, axis=1)
    new_state_hgrn = jnp.stack(new_b, axis=1)
    return (y_prompt, y_sample, new_state_rwkv, new_state_hgrn)
```

```cpp
#include <hip/hip_runtime.h>
#include <hip/hip_cooperative_groups.h>
#include <cstdio>
#include <cstdint>
namespace cg = cooperative_groups;

namespace pg8 {
#define PG8_LAS __attribute__((address_space(3)))
typedef unsigned short bf16_t;
typedef short bf16x8 __attribute__((ext_vector_type(8)));
typedef float f32x4 __attribute__((ext_vector_type(4)));
typedef unsigned u32x4 __attribute__((ext_vector_type(4)));
constexpr int BM = 256, BK = 64, HALF = 128, HTB = HALF * BK * 2, STAGE_BYTES = 8 * HTB, NXCD = 8, WGM = 8;

__host__ __device__ __forceinline__ int lds_byte(int r, int c) { const int st = (r >> 4) * 2 + (c >> 5), rr = r & 15, cc = c & 31, ob = rr * 64 + cc * 2; return st * 1024 + (ob ^ (((ob >> 9) & 1) << 5)); }
__host__ __device__ __forceinline__ void stage_rc(int b, int& R, int& C) { const int st = b / 1024, sb = b % 1024, swz = sb ^ (((sb >> 9) & 1) << 5); R = (st >> 1) * 16 + swz / 64; C = (st & 1) * 32 + (swz % 64) / 2; }
__host__ __device__ __forceinline__ int perm32(int rho) { const int n = rho >> 4, i = rho & 15; return 8 * (i >> 2) + 4 * n + (i & 3); }

struct Unit { int pm, pn; };
struct Gemm { const bf16_t* A; const bf16_t* Bt; int M, N, K, ld; };

struct StaticOrder {
    int nM, nN, nwg, G, c;
    __host__ __device__ void init(int M, int N, int G_, int c_) { nM = M / BM; nN = N / BM; nwg = nM * nN; G = G_; c = c_; }
    __host__ __device__ bool next(int i, Unit& u) const {
        const long L = (long)i * G + c; if (L >= nwg) return false;
        int wgid = (int)L; { const int q = nwg / NXCD, r = nwg % NXCD, xcd = wgid % NXCD, off = wgid / NXCD; wgid = (xcd < r ? xcd * (q + 1) : r * (q + 1) + (xcd - r) * q) + off; }
        const int nig = WGM * nN, gid = wgid / nig, fm = gid * WGM, gsz = (nM - fm) < WGM ? (nM - fm) : WGM;
        u.pm = fm + ((wgid % nig) % gsz); u.pn = (wgid % nig) / gsz; return true;
    }
    __device__ __forceinline__ void a_ready(const Unit&) const {}
    __device__ __forceinline__ void done(const Unit&) const {}
};

typedef __bf16 bf16x2_t __attribute__((ext_vector_type(2)));
typedef float f32x2_t __attribute__((ext_vector_type(2)));
struct OrderOne { int pm, pn; bool on;
    __device__ __forceinline__ bool next(int i, Unit& u) const { if (i > 0 || !on) return false; u.pm = pm; u.pn = pn; return true; }
    __device__ __forceinline__ void a_ready(const Unit&) const {}
    __device__ __forceinline__ void done(const Unit&) const {}
};
__device__ __forceinline__ unsigned cvt_pk_bf16(float lo, float hi) { const f32x2_t v = {lo, hi}; return __builtin_bit_cast(unsigned, __builtin_convertvector(v, bf16x2_t)); }

struct EpiP {
    static constexpr bool PERM = true, AFTER_DRAIN = false;
    bf16_t* pa; bf16_t* pb; const float* lbl;
    __device__ __forceinline__ void operator()(const f32x4 (&acc)[2][2][4][2], const Unit& u, int wr, int wc, int fr, int fq) const {
        const int row0 = u.pm * BM + wr * 64 + fr;
        bf16_t* base; int ldc, colt;
        if (u.pn < 9) { base = pa; ldc = 2304; colt = u.pn * BM; } else { base = pb; ldc = 2560; colt = (u.pn - 9) * BM; }
        const int col0 = colt + wc * 32 + 8 * fq;
        const int ct = u.pn - 9;
        const int kind = (ct < 0) ? 0 : ((ct < 2) ? 1 : ((ct >= 4 && ct < 8) ? 2 : 0));
        float lbv[2][8];
#pragma unroll
        for (int bj = 0; bj < 2; ++bj)
#pragma unroll
            for (int j = 0; j < 8; ++j) lbv[bj][j] = 0.f;
        if (kind == 2) { const int d = (ct - 4) >> 1, cb = (ct & 1) * 256 + wc * 32 + 8 * fq;
#pragma unroll
            for (int bj = 0; bj < 2; ++bj)
#pragma unroll
                for (int j = 0; j < 8; ++j) { const int c = cb + bj * HALF + j; const float l0 = lbl[(0 * 2 + d) * 512 + c], l1 = lbl[(1 * 2 + d) * 512 + c]; lbv[bj][j] = __builtin_amdgcn_rcpf(1.f + __expf(l1 - l0)); } }
#pragma unroll
        for (int ai = 0; ai < 2; ++ai)
#pragma unroll
            for (int m = 0; m < 4; ++m) { bf16_t* rowp = base + (size_t)(row0 + ai * HALF + m * 16) * ldc + col0;
#pragma unroll
                for (int bj = 0; bj < 2; ++bj) { f32x4 v0 = acc[ai][bj][m][0], v1 = acc[ai][bj][m][1];
                    if (kind == 1) {
#pragma unroll
                        for (int j = 0; j < 4; ++j) { v0[j] = v0[j] * __builtin_amdgcn_rcpf(1.f + __expf(-v0[j])); v1[j] = v1[j] * __builtin_amdgcn_rcpf(1.f + __expf(-v1[j])); } }
                    else if (kind == 2) {
#pragma unroll
                        for (int j = 0; j < 4; ++j) { const float la = lbv[bj][j], lb2 = lbv[bj][4 + j];
                            v0[j] = __logf(la + (1.f - la) * __builtin_amdgcn_rcpf(1.f + __expf(-v0[j]))); v1[j] = __logf(lb2 + (1.f - lb2) * __builtin_amdgcn_rcpf(1.f + __expf(-v1[j]))); } }
                    u32x4 w; w.x = cvt_pk_bf16(v0[0], v0[1]); w.y = cvt_pk_bf16(v0[2], v0[3]); w.z = cvt_pk_bf16(v1[0], v1[1]); w.w = cvt_pk_bf16(v1[2], v1[3]);
                    *(u32x4*)(rowp + bj * HALF) = w; } }
    }
};
struct EpiH {
    static constexpr bool PERM = false, AFTER_DRAIN = false;
    const float* xp; const float* xs; const float* gate; bf16_t* hb; bf16_t* h2; int part;
    __device__ __forceinline__ void operator()(const f32x4 (&acc)[2][2][4][2], const Unit& u, int wr, int wc, int fr, int fq) const {
        const int row0 = u.pm * BM + wr * 64 + fr, col0 = u.pn * BM + wc * 32 + 4 * fq;
        const int modrow = (u.pm < 16) ? 0 : 1 + ((u.pm - 16) >> 3);
        f32x4 gv[2][2];
#pragma unroll
        for (int bj = 0; bj < 2; ++bj)
#pragma unroll
            for (int n = 0; n < 2; ++n) gv[bj][n] = *(const f32x4*)(gate + modrow * 1024 + col0 + bj * HALF + n * 16);
#pragma unroll
        for (int ai = 0; ai < 2; ++ai)
#pragma unroll
            for (int m = 0; m < 4; ++m) { const int r = row0 + ai * HALF + m * 16;
                const float* xrow = (u.pm < 16) ? xp + (size_t)r * 1024 : xs + (size_t)(r - 4096) * 1024;
                bf16_t* orow = part ? h2 + (size_t)(r - 16384) * 1024 : hb + (size_t)r * 1024;
#pragma unroll
                for (int bj = 0; bj < 2; ++bj)
#pragma unroll
                    for (int n = 0; n < 2; ++n) { const int c = col0 + bj * HALF + n * 16; f32x4 hv = gv[bj][n] * acc[ai][bj][m][n];
                        if (!part) { const f32x4 xv = *(const f32x4*)(xrow + c); hv = hv + xv; }
                        uint2 o; o.x = cvt_pk_bf16(hv[0], hv[1]); o.y = cvt_pk_bf16(hv[2], hv[3]); *(uint2*)(orow + c) = o; } }
    }
};

template <class Epi, class Sched>
__device__ __forceinline__ void gemm_phase(PG8_LAS unsigned char* lds, const Gemm g, const Sched& S, const Epi& E) {
    int tid = threadIdx.x; asm volatile("" : "+v"(tid)); const int wid = __builtin_amdgcn_readfirstlane(tid >> 6), lane = tid & 63, wr = wid >> 2, wc = wid & 3, fr = lane & 15, fq = lane >> 4;
    const int K = g.K, nt = K / BK, ld = g.ld;
    unsigned voffA[2], voffB[2];
#pragma unroll
    for (int i = 0; i < 2; ++i) { int R, C; stage_rc(tid * 16 + i * 8192, R, C); const int Rb = Epi::PERM ? ((R & ~31) + perm32(R & 31)) : R;
        voffA[i] = (unsigned)(R * ld + C) * 2u; voffB[i] = (unsigned)(Rb * ld + C) * 2u; }
    const size_t kstep = (size_t)(BK * 2);
    const size_t hstep = (size_t)HALF * ld * 2;
    const size_t tstep = 2 * hstep;
    const unsigned ldsw = (unsigned)wid * 1024u;
    const int aoff = lds_byte(wr * 64 + fr, fq * 8), boff = lds_byte(wc * 32 + fr, fq * 8);
#define PG8_SA(b, h) (((b) * 2 + (h)) * HTB)
#define PG8_SB(b, h) ((4 + (b) * 2 + (h)) * HTB)
#define PG8_STAGE(bufoff, gbase, voff) do { _Pragma("unroll") for (int _i = 0; _i < 2; ++_i) \
        __builtin_amdgcn_global_load_lds((const unsigned*)((const char*)(gbase) + (voff)[_i]), (PG8_LAS unsigned*)(lds + (bufoff) + ldsw + _i * 8192), 16, 0, 0); } while (0)
#define PG8_LDA(dst, b, h) do { _Pragma("unroll") for (int m = 0; m < 4; ++m) _Pragma("unroll") for (int k = 0; k < 2; ++k) dst[m][k] = *(const PG8_LAS bf16x8*)(lds + PG8_SA(b, h) + aoff + m * 2048 + k * 1024); } while (0)
#define PG8_LDB(dst, b, h) do { _Pragma("unroll") for (int n = 0; n < 2; ++n) _Pragma("unroll") for (int k = 0; k < 2; ++k) dst[n][k] = *(const PG8_LAS bf16x8*)(lds + PG8_SB(b, h) + boff + n * 2048 + k * 1024); } while (0)
#define PG8_MMA(ai, bj, At, Bt) do { __builtin_amdgcn_s_setprio(1); _Pragma("unroll") for (int m = 0; m < 4; ++m) _Pragma("unroll") for (int n = 0; n < 2; ++n) _Pragma("unroll") for (int k = 0; k < 2; ++k) \
        acc[ai][bj][m][n] = __builtin_amdgcn_mfma_f32_16x16x32_bf16(Bt[n][k], At[m][k], acc[ai][bj][m][n], 0, 0, 0); __builtin_amdgcn_s_setprio(0); } while (0)
#define PG8_WAIT_V(n) asm volatile("s_waitcnt vmcnt(" #n ")" ::: "memory")
#define PG8_WAIT_L(n) asm volatile("s_waitcnt lgkmcnt(" #n ")" ::: "memory")
#define PG8_BAR __builtin_amdgcn_s_barrier()
#define PG8_SCHED __builtin_amdgcn_sched_barrier(0)
    Unit cur, nxt; int ui = 0;
    if (!S.next(0, cur)) return;
    f32x4 acc[2][2][4][2];
#pragma unroll
    for (int a = 0; a < 2; ++a)
#pragma unroll
        for (int b = 0; b < 2; ++b)
#pragma unroll
            for (int m = 0; m < 4; ++m)
#pragma unroll
                for (int n = 0; n < 2; ++n) acc[a][b][m][n] = (f32x4){0.f, 0.f, 0.f, 0.f};
    bf16x8 At[4][2], B0[2][2], B1[2][2];
    const char* cA = (const char*)g.A + (size_t)cur.pm * tstep; const char* cB = (const char*)g.Bt + (size_t)cur.pn * tstep;
    S.a_ready(cur);
    PG8_STAGE(PG8_SB(0, 0), cB, voffB); PG8_STAGE(PG8_SA(0, 0), cA, voffA); PG8_STAGE(PG8_SB(0, 1), cB + hstep, voffB); PG8_STAGE(PG8_SA(0, 1), cA + hstep, voffA);
    if (wr == 1) PG8_BAR;
    PG8_WAIT_V(4); PG8_BAR;
    PG8_STAGE(PG8_SB(1, 0), cB + kstep, voffB); PG8_STAGE(PG8_SA(1, 0), cA + kstep, voffA); PG8_STAGE(PG8_SB(1, 1), cB + hstep + kstep, voffB);
    PG8_WAIT_V(6); PG8_BAR;
    for (;;) {
        const bool has_next = S.next(ui + 1, nxt);
        const char* nA = has_next ? (const char*)g.A + (size_t)nxt.pm * tstep : cA; const char* nB = has_next ? (const char*)g.Bt + (size_t)nxt.pn * tstep : cB;
        for (int t = 0; t < nt; t += 2) {
            const bool last = (t == nt - 2);
            const char* a1 = cA + (size_t)(t + 1) * kstep;
            const char* a2 = last ? nA : cA + (size_t)(t + 2) * kstep; const char* b2 = last ? nB : cB + (size_t)(t + 2) * kstep;
            const char* a3 = a2 + kstep; const char* b3 = b2 + kstep;
            if (last && has_next) S.a_ready(nxt);
            PG8_LDB(B0, 0, 0); PG8_SCHED; PG8_LDA(At, 0, 0); PG8_STAGE(PG8_SA(1, 1), a1 + hstep, voffA);
            PG8_WAIT_L(8); PG8_BAR; PG8_WAIT_L(0); PG8_MMA(0, 0, At, B0); PG8_BAR; PG8_SCHED;
            PG8_LDB(B1, 0, 1); PG8_STAGE(PG8_SB(0, 0), b2, voffB);
            PG8_BAR; PG8_WAIT_L(0); PG8_MMA(0, 1, At, B1); PG8_BAR;
            PG8_LDA(At, 0, 1); PG8_STAGE(PG8_SA(0, 0), a2, voffA);
            PG8_BAR; PG8_WAIT_L(0); PG8_MMA(1, 0, At, B0); PG8_BAR; PG8_SCHED;
            PG8_STAGE(PG8_SB(0, 1), b2 + hstep, voffB);
            PG8_WAIT_V(6); PG8_BAR; PG8_MMA(1, 1, At, B1); PG8_BAR;
            PG8_LDB(B0, 1, 0); PG8_SCHED; PG8_LDA(At, 1, 0); PG8_STAGE(PG8_SA(0, 1), a2 + hstep, voffA);
            PG8_WAIT_L(8); PG8_BAR; PG8_WAIT_L(0); PG8_MMA(0, 0, At, B0); PG8_BAR; PG8_SCHED;
            PG8_LDB(B1, 1, 1); PG8_STAGE(PG8_SB(1, 0), b3, voffB);
            PG8_BAR; PG8_WAIT_L(0); PG8_MMA(0, 1, At, B1); PG8_BAR;
            PG8_LDA(At, 1, 1); PG8_STAGE(PG8_SA(1, 0), a3, voffA);
            PG8_BAR; PG8_WAIT_L(0); PG8_MMA(1, 0, At, B0); PG8_BAR; PG8_SCHED;
            PG8_STAGE(PG8_SB(1, 1), b3 + hstep, voffB);
            PG8_WAIT_V(6); PG8_BAR; PG8_MMA(1, 1, At, B1); PG8_BAR;
        }
        E(acc, cur, wr, wc, fr, fq); S.done(cur);
        if (!has_next) break;
#pragma unroll
        for (int a = 0; a < 2; ++a)
#pragma unroll
            for (int b = 0; b < 2; ++b)
#pragma unroll
                for (int m = 0; m < 4; ++m)
#pragma unroll
                    for (int n = 0; n < 2; ++n) acc[a][b][m][n] = (f32x4){0.f, 0.f, 0.f, 0.f};
        cur = nxt; cA = nA; cB = nB; ++ui;
    }
    PG8_WAIT_V(0);
    if (wr == 0) PG8_BAR;
    PG8_BAR;
#undef PG8_SA
#undef PG8_SB
#undef PG8_STAGE
#undef PG8_LDA
#undef PG8_LDB
#undef PG8_MMA
#undef PG8_WAIT_V
#undef PG8_WAIT_L
#undef PG8_BAR
#undef PG8_SCHED
}
}

using pg8::bf16_t; using pg8::bf16x8; using pg8::f32x4; using pg8::u32x4; using pg8::cvt_pk_bf16;

constexpr int NTOK = 20480, NPTOK = 4096;
constexpr int LDS_BYTES = 159744;
constexpr size_t OUT_Y = (size_t)NTOK * 1024;
constexpr size_t OUT_SA = OUT_Y;
constexpr size_t OUT_SB = OUT_Y + 1048576;
constexpr size_t WS_MODP = 0;
constexpr size_t WS_GATE = 884736;
constexpr size_t WS_BON = 921600;
constexpr size_t WS_WTOUT = 2359296;
constexpr size_t WS_XM = WS_WTOUT + 2097152;
constexpr size_t WS_PB = WS_XM + 41943040;
constexpr size_t WS_PA = WS_PB + 104857600;
constexpr size_t WS_WTIN = WS_PA + 94371840;
constexpr size_t WS_BAR = WS_WTIN + 20971520;
constexpr size_t WS_END = WS_BAR + 16384;

struct Params {
    const float *x_prompt, *x_sample, *state_rwkv, *state_hgrn, *c, *c_ctx, *norm_g, *w_ada, *b_ada, *w_in, *mu_h, *mu_v, *w0, *w2, *a0, *a2, *k_k, *k_a, *r_k,
                *lnx_w, *lnx_b, *lb_logits, *onorm_g, *w_out, *final_g;
    float* out;
    float* modp; float* gate; float* bon; bf16_t* wt_in; bf16_t* wt_out; bf16_t* xm; bf16_t* pa; bf16_t* pb; bf16_t* zs;
    unsigned* bar;
    int ph_lo, ph_hi;
};

__device__ __forceinline__ float bf2f(bf16_t h) { return __uint_as_float(((unsigned)h) << 16); }
__device__ __forceinline__ bf16_t f2bf(float f) { return __builtin_bit_cast(unsigned short, (__bf16)f); }
__device__ __forceinline__ float wave_sum(float v) {
#pragma unroll
    for (int o = 1; o < 64; o <<= 1) v += __shfl_xor(v, o);
    return v;
}
template <int CTRL> __device__ __forceinline__ float dppf(float x) { return __int_as_float(__builtin_amdgcn_update_dpp(0, __float_as_int(x), CTRL, 0xf, 0xf, true)); }
__device__ __forceinline__ float red8(float x) { x += dppf<0xB1>(x); x += dppf<0x4E>(x); x += dppf<0x141>(x); return x; }
__device__ __forceinline__ float red16(float x) { x = red8(x); x += dppf<0x140>(x); return x; }
__device__ __forceinline__ float wave_sum_fast(float x) {
    x = red16(x);
    const float a = __builtin_amdgcn_readlane(x, 0), b = __builtin_amdgcn_readlane(x, 16), c = __builtin_amdgcn_readlane(x, 32), d = __builtin_amdgcn_readlane(x, 48);
    return (a + b) + (c + d);
}
__device__ __forceinline__ float sigmoidf_(float x) { return __builtin_amdgcn_rcpf(1.f + __expf(-x)); }
__device__ __forceinline__ void unpack8(const u32x4 w, float* x) {
    x[0] = __uint_as_float(w.x << 16); x[1] = __uint_as_float(w.x & 0xffff0000u); x[2] = __uint_as_float(w.y << 16); x[3] = __uint_as_float(w.y & 0xffff0000u);
    x[4] = __uint_as_float(w.z << 16); x[5] = __uint_as_float(w.z & 0xffff0000u); x[6] = __uint_as_float(w.w << 16); x[7] = __uint_as_float(w.w & 0xffff0000u);
}
__device__ __forceinline__ int otid() { int t = threadIdx.x; asm volatile("" : "+v"(t)); return t; }
__device__ __forceinline__ void ld8f(const float* p, float* x) { const float4 a = *(const float4*)p, b = *(const float4*)(p + 4); x[0] = a.x; x[1] = a.y; x[2] = a.z; x[3] = a.w; x[4] = b.x; x[5] = b.y; x[6] = b.z; x[7] = b.w; }
__device__ __forceinline__ void lds_fence_wave() { asm volatile("s_waitcnt lgkmcnt(0)" ::: "memory"); __builtin_amdgcn_wave_barrier(); }

__device__ __forceinline__ void transpose_item(const float* __restrict__ W, int K, int N, bf16_t* __restrict__ WT, float* scr, int item, int lane) {
    const int nblk = N / 32, kb = item / nblk, nb = item % nblk, k0 = 64 * kb, n0 = 32 * nb;
#pragma unroll 8
    for (int i = 0; i < 32; ++i) { const int kk = 2 * i + (lane >> 5); scr[kk * 33 + (lane & 31)] = W[(size_t)(k0 + kk) * N + n0 + (lane & 31)]; }
    lds_fence_wave();
    const int c = lane & 7;
#pragma unroll
    for (int j = 0; j < 4; ++j) { const int n = (lane >> 3) + 8 * j; const float* s = scr + (8 * c) * 33 + n;
        u32x4 o; o.x = cvt_pk_bf16(s[0 * 33], s[1 * 33]); o.y = cvt_pk_bf16(s[2 * 33], s[3 * 33]); o.z = cvt_pk_bf16(s[4 * 33], s[5 * 33]); o.w = cvt_pk_bf16(s[6 * 33], s[7 * 33]);
        *(u32x4*)(WT + (size_t)(n0 + n) * K + k0 + 8 * c) = o; }
    lds_fence_wave();
}

__device__ __forceinline__ void phase0(const Params& p, unsigned char* smem) {
    const int tid = otid(), lane = tid & 63, wave = tid >> 6;
    const int gw = blockIdx.x * 8 + wave, NGW = gridDim.x * 8;
    float* sl = (float*)smem;
    float* scr = (float*)(smem + 49152) + wave * (64 * 33);
    if ((int)blockIdx.x * 8 < 384) {
        for (int e = tid; e < 9 * 1024; e += 512) { const int j = e >> 10, k = e & 1023; const float cv = (j == 0) ? p.c_ctx[k] : p.c[(j - 1) * 1024 + k]; sl[k * 12 + j] = cv / (1.f + __expf(-cv)); }
        __syncthreads();
        if (gw < 384) {
            const int cb = gw % 48, kc = gw / 48, col = cb * 64 + lane;
            float a0 = 0, a1 = 0, a2 = 0, a3 = 0, a4 = 0, a5 = 0, a6 = 0, a7 = 0, a8 = 0;
#pragma unroll 16
            for (int k = kc * 128; k < kc * 128 + 128; ++k) {
                const float wv = p.w_ada[(size_t)k * 3072 + col];
                const float4* s4 = (const float4*)(sl + k * 12); const float4 s0 = s4[0], s1 = s4[1], s2 = s4[2];
                a0 += s0.x * wv; a1 += s0.y * wv; a2 += s0.z * wv; a3 += s0.w * wv; a4 += s1.x * wv; a5 += s1.y * wv; a6 += s1.z * wv; a7 += s1.w * wv; a8 += s2.x * wv;
            }
            float* mp = p.modp + (size_t)kc * 9 * 3072 + col;
            mp[0 * 3072] = a0; mp[1 * 3072] = a1; mp[2 * 3072] = a2; mp[3 * 3072] = a3; mp[4 * 3072] = a4; mp[5 * 3072] = a5; mp[6 * 3072] = a6; mp[7 * 3072] = a7; mp[8 * 3072] = a8;
        }
    }
    for (int it = gw; it < 2432 + 512; it += NGW) {
        if (it < 2432) transpose_item(p.w_in, 1024, 4864, p.wt_in, scr, it, lane);
        else transpose_item(p.w_out, 1024, 1024, p.wt_out, scr, it - 2432, lane);
    }
}

__device__ __forceinline__ void phase1(const Params& p, unsigned char* smem) {
    const int tid = otid(), lane = tid & 63, wave = tid >> 6;
    float* gs = (float*)smem; float* sh = gs + 1024;
    if (blockIdx.x < 9) {
        const int row = blockIdx.x;
        for (int c = tid; c < 1024; c += 512) { float s = p.b_ada[2048 + c];
#pragma unroll
            for (int kc = 0; kc < 8; ++kc) s += p.modp[((size_t)kc * 9 + row) * 3072 + 2048 + c];
            p.gate[row * 1024 + c] = s; }
    }
    const int G = gridDim.x, per = (2560 + G - 1) / G; const int g0 = blockIdx.x * per, g1 = (g0 + per) < 2560 ? (g0 + per) : 2560;
    int cur = -1;
    for (int grp = g0; grp < g1; ++grp) {
        const int tok0 = grp * 8; const int row = tok0 < NPTOK ? 0 : 1 + ((tok0 - NPTOK) >> 11);
        if (row != cur) {
            __syncthreads();
            for (int c = tid; c < 1024; c += 512) { float s0 = p.b_ada[c], s1 = p.b_ada[1024 + c];
#pragma unroll
                for (int kc = 0; kc < 8; ++kc) { s0 += p.modp[((size_t)kc * 9 + row) * 3072 + c]; s1 += p.modp[((size_t)kc * 9 + row) * 3072 + 1024 + c]; }
                gs[c] = p.norm_g[c] * (1.f + s1); sh[c] = s0; }
            __syncthreads(); cur = row;
        }
        const bool two = (grp + 1 < g1) && ((tok0 + 8 < NPTOK ? 0 : 1 + ((tok0 + 8 - NPTOK) >> 11)) == row);
        const int tokA = tok0 + wave, tokB = two ? tokA + 8 : tokA;
        const float* xa = tokA < NPTOK ? p.x_prompt + (size_t)tokA * 1024 : p.x_sample + (size_t)(tokA - NPTOK) * 1024;
        const float* xb = tokB < NPTOK ? p.x_prompt + (size_t)tokB * 1024 : p.x_sample + (size_t)(tokB - NPTOK) * 1024;
        float4 va[4], vb[4]; float sa = 0.f, sb = 0.f;
#pragma unroll
        for (int j = 0; j < 4; ++j) { va[j] = ((const float4*)xa)[lane + 64 * j]; vb[j] = ((const float4*)xb)[lane + 64 * j]; }
#pragma unroll
        for (int j = 0; j < 4; ++j) { sa += va[j].x * va[j].x + va[j].y * va[j].y + va[j].z * va[j].z + va[j].w * va[j].w; sb += vb[j].x * vb[j].x + vb[j].y * vb[j].y + vb[j].z * vb[j].z + vb[j].w * vb[j].w; }
        sa = wave_sum_fast(sa); sb = wave_sum_fast(sb);
        const float ra = rsqrtf(sa * (1.f / 1024.f) + 1e-6f), rb = rsqrtf(sb * (1.f / 1024.f) + 1e-6f);
#pragma unroll
        for (int j = 0; j < 4; ++j) { const int c = 4 * (lane + 64 * j); const float4 g4 = *(const float4*)(gs + c), h4 = *(const float4*)(sh + c);
            uint2 o; o.x = cvt_pk_bf16(va[j].x * ra * g4.x + h4.x, va[j].y * ra * g4.y + h4.y); o.y = cvt_pk_bf16(va[j].z * ra * g4.z + h4.z, va[j].w * ra * g4.w + h4.w);
            *(uint2*)(p.xm + (size_t)tokA * 1024 + c) = o;
            if (two) { uint2 o2; o2.x = cvt_pk_bf16(vb[j].x * rb * g4.x + h4.x, vb[j].y * rb * g4.y + h4.y); o2.y = cvt_pk_bf16(vb[j].z * rb * g4.z + h4.z, vb[j].w * rb * g4.w + h4.w);
                *(uint2*)(p.xm + (size_t)tokB * 1024 + c) = o2; } }
        if (two) ++grp;
    }
}

__device__ __forceinline__ void phase3(const Params& p) {
    const int tid = otid(), lane = tid & 63, wave = tid >> 6;
    const int gw = blockIdx.x * 8 + wave, NGW = gridDim.x * 8;
    bf16_t* PS = (bf16_t*)p.out;
    for (int item = gw; item < NTOK * 288 / 64; item += NGW) {
        const int idx = item * 64 + lane, tok = idx / 288, col = (idx - tok * 288) * 8;
        const bool grid = tok >= NPTOK; const int t = grid ? (tok - NPTOK) & 2047 : tok & 255;
        bool hp, hn, vu = false, vd = false;
        if (!grid) { hp = t > 0; hn = t < 255; } else { const int cgx = t & 63, rgy = t >> 6; hp = cgx > 0; hn = cgx < 63; vu = rgy > 0; vd = rgy < 31; }
        const bf16_t* pc = p.pa + (size_t)tok * 2304 + col;
        const u32x4 c0 = *(const u32x4*)pc, c1 = *(const u32x4*)(pc + (hp ? -2304 : 0)), c2 = *(const u32x4*)(pc + (hn ? 2304 : 0));
        const u32x4 c3 = *(const u32x4*)(pc + (vu ? -64 * 2304 : 0)), c4 = *(const u32x4*)(pc + (vd ? 64 * 2304 : 0));
        float mh[8], mv[8]; ld8f(p.mu_h + col, mh); ld8f(p.mu_v + col, mv);
        const float whp = hp ? 0.5f : 0.f, whn = hn ? 0.5f : 0.f, wvu = vu ? 0.5f : 0.f, wvd = vd ? 0.5f : 0.f, gsel = grid ? 1.f : 0.f;
        float x[8], xa[8], xb[8], res[8];
        unpack8(c0, x); unpack8(c1, xa); unpack8(c2, xb);
#pragma unroll
        for (int j = 0; j < 8; ++j) res[j] = x[j] + mh[j] * (whp * xa[j] + whn * xb[j] - x[j]);
        unpack8(c3, xa); unpack8(c4, xb);
#pragma unroll
        for (int j = 0; j < 8; ++j) res[j] += gsel * mv[j] * (wvu * xa[j] + wvd * xb[j] - x[j]);
        const bool is_za = (col >= 1536 && col < 2048), is_wl = (col >= 2048 && ((col - 2048) & 64) == 0);
        if (is_wl) {
#pragma unroll
            for (int j = 0; j < 8; ++j) { const float e2 = __expf(2.f * res[j]); res[j] = 1.f - 2.f * __builtin_amdgcn_rcpf(e2 + 1.f); } }
        if (is_za) {
#pragma unroll
            for (int j = 0; j < 8; ++j) res[j] = res[j] * sigmoidf_(res[j]); }
        u32x4 o; o.x = cvt_pk_bf16(res[0], res[1]); o.y = cvt_pk_bf16(res[2], res[3]); o.z = cvt_pk_bf16(res[4], res[5]); o.w = cvt_pk_bf16(res[6], res[7]);
        bf16_t* dst = is_za ? (p.zs + (size_t)tok * 512 + (col - 1536)) : (PS + (size_t)tok * 1792 + (col < 1536 ? col : col - 512));
        *(u32x4*)dst = o;
    }
}

typedef short s16x4 __attribute__((ext_vector_type(4)));
__device__ __forceinline__ s16x4 pack4(const f32x4 v) { uint2 r; r.x = cvt_pk_bf16(v[0], v[1]); r.y = cvt_pk_bf16(v[2], v[3]); return __builtin_bit_cast(s16x4, r); }
#define MFMA16(a, b, c) __builtin_amdgcn_mfma_f32_16x16x16bf16_1k((a), (b), (c), 0, 0, 0)
__device__ __forceinline__ void rwkv_item(const Params& p, unsigned char* smem, int seq, int d, int h, bool keep_wl = false) {
    const int tid = otid(), lane = tid & 63, wave = tid >> 6;
    const bool grid = seq >= 16; const int T = grid ? 2048 : 256; const int g0 = grid ? NPTOK + (seq - 16) * 2048 : seq * 256; const int bidx = grid ? seq - 16 : seq;
    float* RF = (float*)(smem + 0);
    float* KEF = (float*)(smem + 8192);
    float* EF = (float*)(smem + 16384);
    float* KAP = (float*)(smem + 24576);
    float* BF = (float*)(smem + 32768);
    bf16_t* VTb0 = (bf16_t*)(smem + 40960);
    bf16_t* LWb = (bf16_t*)(smem + 51200);
    bf16_t* QH0 = (bf16_t*)(smem + 60416);
    bf16_t* BK = (bf16_t*)(smem + 78848);
    bf16_t* KP0 = (bf16_t*)(smem + 88064);
    bf16_t* AMs0 = (bf16_t*)(smem + 108544);
    float* G150 = (float*)(smem + 122880);
    float* YOUT0 = (float*)(smem + 123904);
    float* BONL = (float*)(smem + 140288);
    bf16_t* WL = (bf16_t*)(smem + 140672);
    const int nmc = T / 32;
    bf16_t* YA = p.pa + (size_t)d * NTOK * 512;
    const bf16_t* PS = (const bf16_t*)p.out;
    float* BON = p.bon + (size_t)d * NTOK * 8;
    const int lr = lane & 15, lq = lane >> 4;

    f32x4 Lacc = {0.f, 0.f, 0.f, 0.f};
    f32x4 ST[4];
#pragma unroll
    for (int kt = 0; kt < 4; ++kt) ST[kt] = (f32x4){0.f, 0.f, 0.f, 0.f};
    if (wave < 4 && grid) { const float* st = p.state_rwkv + ((size_t)(bidx * 2 + d) * 8 + h) * 4096 + (16 * wave + lr) * 64;
#pragma unroll
        for (int kt = 0; kt < 4; ++kt) { const float4 s4 = *(const float4*)(st + 16 * kt + 4 * lq); ST[kt] = (f32x4){s4.x, s4.y, s4.z, s4.w}; } }
    if (!keep_wl) for (int e = tid; e < 2 * 64 * 64; e += 512) { const int ty = e >> 12, k = (e >> 6) & 63, n = e & 63;
        const float wv = ty ? p.a2[(size_t)(d * 64 + k) * 512 + 64 * h + n] : p.w2[(size_t)(d * 64 + k) * 512 + 64 * h + n];
        WL[(ty * 64 + n) * 72 + k] = f2bf(wv); }
    const float ka3 = p.k_a[64 * h + (tid & 63)];
    float kq[8]; ld8f(p.k_k + 64 * h + (tid & 7) * 8, kq);
    float w0c = 0.f, a0c = 0.f, kac = 0.f, rkc = 0.f;
    { const int n = 64 * h + 16 * (wave & 3) + lr; w0c = p.w0[d * 512 + n]; a0c = p.a0[d * 512 + n]; kac = p.k_a[n]; rkc = p.r_k[n]; }

    u32x4 L[3];
#pragma unroll
    for (int m = 0; m < 3; ++m) L[m] = (u32x4){0u, 0u, 0u, 0u};
    auto A_load = [&](int c) {
#pragma unroll
        for (int m = 0; m < 3; ++m) { const int it = tid + 512 * m;
            if (it < 1280) { const int grp = it >> 8, i = (it >> 3) & 31, v8 = it & 7;
                const int col = (grp < 3 ? grp * 512 + 64 * h : 1536 + 128 * d + (grp - 3) * 64) + v8 * 8;
                const int step = c * 32 + i, t = d ? T - 1 - step : step;
                L[m] = *(const u32x4*)(PS + (size_t)(g0 + t) * 1792 + col); } }
    };
    auto prep = [&](int c) {
        const int par = c & 1;
        bf16_t* VTb = VTb0 + par * 2560; bf16_t* QH = QH0 + par * 4608; bf16_t* KP = KP0 + par * 5120; bf16_t* AMs = AMs0 + par * 2560; float* G15 = G150 + par * 128;
        float* BONc = BONL + (c % 3) * 32;
        __builtin_amdgcn_s_waitcnt(0);
        if (tid < 32) BONc[tid] = 0.f;
#pragma unroll
        for (int m = 0; m < 3; ++m) { const int it = tid + 512 * m;
            if (it < 1280) { const int grp = __builtin_amdgcn_readfirstlane(it >> 8), i = (it >> 3) & 31, v8 = it & 7;
                const int cc = v8 * 8; const u32x4 w = L[m];
                if (grp < 2) { float res[8]; unpack8(w, res); float* dst = RF + grp * 2048 + i * 64 + cc;
                    *(float4*)dst = make_float4(res[0], res[1], res[2], res[3]); *(float4*)(dst + 4) = make_float4(res[4], res[5], res[6], res[7]);
                    if (grp == 1) {
                        float ss = 0.f;
#pragma unroll
                        for (int j = 0; j < 8; ++j) { res[j] *= kq[j]; ss += res[j] * res[j]; }
                        ss = red8(ss);
                        const float inv = __builtin_amdgcn_rcpf(fmaxf(__builtin_amdgcn_sqrtf(ss), 1e-12f));
                        *(float4*)(KAP + i * 64 + cc) = make_float4(res[0] * inv, res[1] * inv, res[2] * inv, res[3] * inv); *(float4*)(KAP + i * 64 + cc + 4) = make_float4(res[4] * inv, res[5] * inv, res[6] * inv, res[7] * inv); }
                } else if (grp == 2) {
                    VTb[(cc + 0) * 40 + i] = (bf16_t)(w.x & 0xffffu); VTb[(cc + 1) * 40 + i] = (bf16_t)(w.x >> 16); VTb[(cc + 2) * 40 + i] = (bf16_t)(w.y & 0xffffu); VTb[(cc + 3) * 40 + i] = (bf16_t)(w.y >> 16);
                    VTb[(cc + 4) * 40 + i] = (bf16_t)(w.z & 0xffffu); VTb[(cc + 5) * 40 + i] = (bf16_t)(w.z >> 16); VTb[(cc + 6) * 40 + i] = (bf16_t)(w.w & 0xffffu); VTb[(cc + 7) * 40 + i] = (bf16_t)(w.w >> 16);
                } else {
                    *(u32x4*)(LWb + (grp - 3) * 2304 + i * 72 + cc) = w;
                } } }
        if (c + 1 < nmc) A_load(c + 1);
        __syncthreads();
        { const int wn = wave & 3, u = wave >> 2, n = 16 * wn + lr;
            f32x4 accw = {0.f, 0.f, 0.f, 0.f}, acca = {0.f, 0.f, 0.f, 0.f};
#pragma unroll
            for (int q = 0; q < 2; ++q) {
                const bf16x8 aw = *(const bf16x8*)(LWb + (16 * u + lr) * 72 + q * 32 + lq * 8);
                const bf16x8 aa = *(const bf16x8*)(LWb + 2304 + (16 * u + lr) * 72 + q * 32 + lq * 8);
                const bf16x8 bw = *(const bf16x8*)(WL + (16 * wn + lr) * 72 + q * 32 + lq * 8);
                const bf16x8 ba = *(const bf16x8*)(WL + (64 + 16 * wn + lr) * 72 + q * 32 + lq * 8);
                accw = __builtin_amdgcn_mfma_f32_16x16x32_bf16(aw, bw, accw, 0, 0, 0);
                acca = __builtin_amdgcn_mfma_f32_16x16x32_bf16(aa, ba, acca, 0, 0, 0);
            }
            float ee[4], av[4];
#pragma unroll
            for (int j = 0; j < 4; ++j) { ee[j] = __builtin_amdgcn_rcpf(1.f + __expf(-(w0c + accw[j]))) * 0.60653066f; av[j] = __builtin_amdgcn_rcpf(1.f + __expf(-(a0c + acca[j]))); }
            const float p1 = ee[0] + ee[1], p2 = p1 + ee[2], q4 = p2 + ee[3];
            const float t1 = __shfl_up(q4, 16); const float s1 = q4 + (lq >= 1 ? t1 : 0.f);
            const float t2 = __shfl_up(s1, 32); const float s2 = s1 + (lq >= 2 ? t2 : 0.f);
            const float etot = __shfl(s2, 48 + lr), offp = s2 - q4;
            const float Gtot = __expf(-etot); float Gprev = __expf(-offp), E = offp;
            float kpk[4], kpb[4];
#pragma unroll
            for (int j = 0; j < 4; ++j) { const int tau = 4 * lq + j, i = 16 * u + tau;
                E += ee[j];
                const float Gm1 = Gprev, G = __expf(-E), iG = __builtin_amdgcn_rcpf(G), tail = iG * Gtot; Gprev = G;
                const float kap = KAP[i * 64 + n], r = RF[i * 64 + n], a = av[j]; const float ke = KEF[i * 64 + n] * (1.f + (a - 1.f) * kac), b = kap * a;
                QH[(u * 32 + tau) * 72 + n] = f2bf(kap * Gm1); QH[(u * 32 + 16 + tau) * 72 + n] = f2bf(r * G);
                BK[(u * 32 + tau) * 72 + n] = f2bf(b * iG); BK[(u * 32 + 16 + tau) * 72 + n] = f2bf(ke * iG);
                kpk[j] = ke * tail; kpb[j] = b * tail;
                float pbn = 0.5f * r * ke * rkc; pbn = red16(pbn);
                if (lr == 0) atomicAdd(&BONc[i], pbn); }
            { uint2 o; o.x = cvt_pk_bf16(kpk[0], kpk[1]); o.y = cvt_pk_bf16(kpk[2], kpk[3]); *(uint2*)(KP + ((u * 2 + 0) * 64 + n) * 20 + 4 * lq) = o;
              uint2 o2; o2.x = cvt_pk_bf16(kpb[0], kpb[1]); o2.y = cvt_pk_bf16(kpb[2], kpb[3]); *(uint2*)(KP + ((u * 2 + 1) * 64 + n) * 20 + 4 * lq) = o2; }
            if (lq == 3) G15[u * 64 + n] = Gtot;
        }
        __syncthreads();
    };
    auto S4 = [&](int c) {
        const int par = c & 1; const bf16_t* QH = QH0 + par * 4608; bf16_t* AMs = AMs0 + par * 2560;
        { int u, mi, ni;
          if (wave == 4 || wave == 5) { u = wave - 4; mi = 0; ni = 0; }
          else { const int idx = wave < 4 ? wave : wave - 2; u = idx / 3; const int r3 = idx - 3 * u; mi = (r3 == 0) ? 0 : 1; ni = (r3 == 1) ? 0 : 1; }
          f32x4 acc = {0.f, 0.f, 0.f, 0.f};
#pragma unroll
          for (int q = 0; q < 2; ++q) { const bf16x8 A = *(const bf16x8*)(QH + (u * 32 + 16 * mi + lr) * 72 + q * 32 + lq * 8); const bf16x8 B = *(const bf16x8*)(BK + (u * 32 + 16 * ni + lr) * 72 + q * 32 + lq * 8);
              acc = __builtin_amdgcn_mfma_f32_16x16x32_bf16(A, B, acc, 0, 0, 0); }
          if (wave == 4 || wave == 5) Lacc = acc;
          else {
#pragma unroll
              for (int j = 0; j < 4; ++j) { const int t = lq * 4 + j, sidx = lr;
                  const int mat = (mi == 0) ? 1 : (ni == 1 ? 2 : 3); const bool keep = (mi == 0) ? (sidx < t) : (sidx <= t);
                  AMs[((u * 4 + mat) * 16 + t) * 20 + sidx] = f2bf(keep ? acc[j] : 0.f); } } }
    };
    auto S5 = [&](int c) {
        bf16_t* AMs = AMs0 + (c & 1) * 2560;
        const int u = wave - 4, cI = lr;
        float x[16];
#pragma unroll
        for (int t = 0; t < 16; ++t) x[t] = (t == cI) ? 1.f : 0.f;
#pragma unroll
        for (int sidx = 0; sidx < 15; ++sidx) {
#pragma unroll
            for (int t = sidx + 1; t < 16; ++t) { const float l = __int_as_float(__builtin_amdgcn_readlane(__float_as_int(Lacc[t & 3]), 16 * (t >> 2) + sidx)); x[t] -= l * x[sidx]; } }
        if (lq == 0) {
#pragma unroll
            for (int t = 0; t < 16; ++t) AMs[((u * 4 + 0) * 16 + t) * 20 + cI] = f2bf(-x[t]); }
    };
    auto S6 = [&](int c) {
        const int par = c & 1;
        const bf16_t* VTb = VTb0 + par * 2560; const bf16_t* QH = QH0 + par * 4608; const bf16_t* KP = KP0 + par * 5120; const bf16_t* AMs = AMs0 + par * 2560; const float* G15 = G150 + par * 128;
        float* YOUT = YOUT0 + par * 2048;
#pragma unroll 1
        for (int u = 0; u < 2; ++u) {
            s16x4 STb[4];
#pragma unroll
            for (int kt = 0; kt < 4; ++kt) STb[kt] = pack4(ST[kt]);
            f32x4 W = {0.f, 0.f, 0.f, 0.f}, RS = {0.f, 0.f, 0.f, 0.f};
#pragma unroll
            for (int kt = 0; kt < 4; ++kt) { const s16x4 ak = *(const s16x4*)(QH + (u * 32 + lr) * 72 + 16 * kt + 4 * lq); const s16x4 ar = *(const s16x4*)(QH + (u * 32 + 16 + lr) * 72 + 16 * kt + 4 * lq);
                W = MFMA16(ak, STb[kt], W); RS = MFMA16(ar, STb[kt], RS); }
            const s16x4 Vb = *(const s16x4*)(VTb + (16 * wave + lr) * 40 + 16 * u + 4 * lq);
            const s16x4 aTi = *(const s16x4*)(AMs + ((u * 4 + 0) * 16 + lr) * 20 + 4 * lq), aKk = *(const s16x4*)(AMs + ((u * 4 + 1) * 16 + lr) * 20 + 4 * lq);
            const s16x4 aKr = *(const s16x4*)(AMs + ((u * 4 + 2) * 16 + lr) * 20 + 4 * lq), aBr = *(const s16x4*)(AMs + ((u * 4 + 3) * 16 + lr) * 20 + 4 * lq);
            const f32x4 Z = MFMA16(aKk, Vb, W);
            const s16x4 Zb = pack4(Z);
            const f32x4 zero = {0.f, 0.f, 0.f, 0.f};
            const f32x4 U = MFMA16(aTi, Zb, zero);
            const s16x4 Ub = pack4(U);
            f32x4 Y = MFMA16(aKr, Vb, RS); Y = MFMA16(aBr, Ub, Y);
#pragma unroll
            for (int j = 0; j < 4; ++j) YOUT[(16 * u + 4 * lq + j) * 64 + 16 * wave + lr] = Y[j];
#pragma unroll
            for (int kt = 0; kt < 4; ++kt) { const float4 g4 = *(const float4*)(G15 + u * 64 + 16 * kt + 4 * lq);
                f32x4 sv = ST[kt]; sv[0] *= g4.x; sv[1] *= g4.y; sv[2] *= g4.z; sv[3] *= g4.w;
                const s16x4 akp = *(const s16x4*)(KP + ((u * 2 + 0) * 64 + 16 * kt + lr) * 20 + 4 * lq), abp = *(const s16x4*)(KP + ((u * 2 + 1) * 64 + 16 * kt + lr) * 20 + 4 * lq);
                sv = MFMA16(akp, Vb, sv); sv = MFMA16(abp, Ub, sv); ST[kt] = sv; }
        }
    };
    auto writeout = [&](int c) {
        const float* YOUT = YOUT0 + (c & 1) * 2048; const float* BONc = BONL + (c % 3) * 32;
        const int tid3 = tid - 384;
        for (int e = tid3; e < 512; e += 128) { const int i = e >> 4, c4 = (e & 15) * 4;
            const int step = c * 32 + i, t = d ? T - 1 - step : step;
            const float4 y4 = *(const float4*)(YOUT + i * 64 + c4);
            uint2 o; o.x = cvt_pk_bf16(y4.x, y4.y); o.y = cvt_pk_bf16(y4.z, y4.w);
            *(uint2*)(YA + (size_t)(g0 + t) * 512 + 64 * h + c4) = o; }
        if (tid3 < 32) { const int st2 = c * 32 + tid3, t2 = d ? T - 1 - st2 : st2; BON[(size_t)(g0 + t2) * 8 + h] = BONc[tid3]; }
    };

    __syncthreads();
    A_load(0);
    prep(0);
    S4(0);
    if (wave == 4 || wave == 5) S5(0);
    __syncthreads();
    for (int c = 0; c < nmc; ++c) {
        const bool more = (c + 1) < nmc;
        if (more) { prep(c + 1); S4(c + 1); }
        if (wave < 4) S6(c);
        else if (wave < 6) { if (more) S5(c + 1); }
        else if (c > 0) writeout(c - 1);
        __syncthreads();
    }
    if (wave >= 6) writeout(nmc - 1);
    if (wave < 4 && !grid) { float* st = p.out + OUT_SA + ((size_t)(bidx * 2 + d) * 8 + h) * 4096 + (16 * wave + lr) * 64;
#pragma unroll
        for (int kt = 0; kt < 4; ++kt) *(float4*)(st + 16 * kt + 4 * lq) = make_float4(ST[kt][0], ST[kt][1], ST[kt][2], ST[kt][3]); }
    __syncthreads();
}

__device__ __forceinline__ void hgrn_item(const Params& p, unsigned char* smem, int seq, int d, int h, int vh) {
    const int tid = otid(), lane = tid & 63, wave = tid >> 6;
    const bool grid = seq >= 16; const int T = grid ? 2048 : 256; const int g0 = grid ? NPTOK + (seq - 16) * 2048 : seq * 256; const int bidx = grid ? seq - 16 : seq;
    bf16_t* QT = (bf16_t*)(smem + 0);
    bf16_t* KT = (bf16_t*)(smem + 17408);
    bf16_t* ST = (bf16_t*)(smem + 34816);
    bf16_t* KH = (bf16_t*)(smem + 52224);
    bf16_t* AM = (bf16_t*)(smem + 70656);
    bf16_t* VT = (bf16_t*)(smem + 79872);
    float* GC = (float*)(smem + 89088);
    float* GSUM = (float*)(smem + 89600);
    const int nch = T / 64;
    const int lr = lane & 15, lq = lane >> 4;
    bf16_t* OB = p.pa + (size_t)NTOK * 1024 + (size_t)d * NTOK * 512;
#ifdef SKIP_HGRN
    for (int e = tid; e < T * 64; e += 512) OB[(size_t)(g0 + (e >> 6)) * 512 + 128 * h + 64 * vh + (e & 63)] = 0;
    if (!grid) for (int e = tid; e < 8192; e += 512) p.out[OUT_SB + ((size_t)((bidx * 2 + d) * 4 + h) * 128 + (e >> 6)) * 128 + 64 * vh + (e & 63)] = 0.f;
    return;
#endif

    f32x4 sacc[4];
#pragma unroll
    for (int x = 0; x < 4; ++x) { const int id = 4 * wave + x, tv = id >> 3, tk = id & 7;
#pragma unroll
        for (int j = 0; j < 4; ++j) { const int v = tv * 16 + lq * 4 + j, k = tk * 16 + lr;
            const float s = grid ? p.state_hgrn[((size_t)((bidx * 2 + d) * 4 + h) * 128 + k) * 128 + 64 * vh + v] : 0.f;
            sacc[x][j] = s; ST[v * 136 + k] = f2bf(s); } }
    const int kch = 16 * wave + (lane & 15), qd = lane >> 4;

    bf16_t rf[16], rq[16]; u32x4 rv = {0u, 0u, 0u, 0u};
    auto load_raw = [&](int c) {
#pragma unroll
        for (int ii = 0; ii < 16; ++ii) { const int step = c * 64 + 16 * qd + ii, t = d ? T - 1 - step : step; const bf16_t* row = p.pb + (size_t)(g0 + t) * 2560;
            rf[ii] = row[1024 + 512 * d + 128 * h + kch]; rq[ii] = row[128 * h + kch]; }
        { const int s = tid >> 3, v8 = (tid & 7) * 8; const int step = c * 64 + s, t = d ? T - 1 - step : step;
          rv = *(const u32x4*)(p.pb + (size_t)(g0 + t) * 2560 + 512 + 128 * h + 64 * vh + v8); }
    };
    load_raw(0);
    for (int c = 0; c < nch; ++c) {
        float G[16], qv[16], kv[16]; float run = 0.f;
#pragma unroll
        for (int ii = 0; ii < 16; ++ii) {
            const float g = bf2f(rf[ii]);
            run += g; G[ii] = run; qv[ii] = bf2f(rq[ii]); kv[ii] = 1.f - __expf(g); }
        { const int s = tid >> 3, v8 = (tid & 7) * 8; const u32x4 w = rv;
          VT[(v8 + 0) * 72 + s] = (bf16_t)(w.x & 0xffffu); VT[(v8 + 1) * 72 + s] = (bf16_t)(w.x >> 16); VT[(v8 + 2) * 72 + s] = (bf16_t)(w.y & 0xffffu); VT[(v8 + 3) * 72 + s] = (bf16_t)(w.y >> 16);
          VT[(v8 + 4) * 72 + s] = (bf16_t)(w.z & 0xffffu); VT[(v8 + 5) * 72 + s] = (bf16_t)(w.z >> 16); VT[(v8 + 6) * 72 + s] = (bf16_t)(w.w & 0xffffu); VT[(v8 + 7) * 72 + s] = (bf16_t)(w.w >> 16); }
        if (c + 1 < nch) load_raw(c + 1);
        const float t1 = __shfl_up(run, 16); const float s1 = run + (qd >= 1 ? t1 : 0.f);
        const float t2 = __shfl_up(s1, 32); const float s2 = s1 + (qd >= 2 ? t2 : 0.f);
        const float off = s2 - run, tot = __shfl(s2, 48 + (lane & 15));
        const float etot = __expf(tot);
        float khv[16];
#pragma unroll
        for (int ii = 0; ii < 16; ++ii) { const int i = 16 * qd + ii; const float Gi = G[ii] + off;
            const float eg = __expf(Gi), ieg = __builtin_amdgcn_rcpf(eg), kie = kv[ii] * ieg;
            QT[i * 136 + kch] = f2bf(qv[ii] * eg); KT[i * 136 + kch] = f2bf(kie); khv[ii] = kie * etot; }
        { u32x4 o0, o1;
          o0.x = cvt_pk_bf16(khv[0], khv[1]); o0.y = cvt_pk_bf16(khv[2], khv[3]); o0.z = cvt_pk_bf16(khv[4], khv[5]); o0.w = cvt_pk_bf16(khv[6], khv[7]);
          o1.x = cvt_pk_bf16(khv[8], khv[9]); o1.y = cvt_pk_bf16(khv[10], khv[11]); o1.z = cvt_pk_bf16(khv[12], khv[13]); o1.w = cvt_pk_bf16(khv[14], khv[15]);
          *(u32x4*)(KH + kch * 72 + 16 * qd) = o0; *(u32x4*)(KH + kch * 72 + 16 * qd + 8) = o1; }
        if (qd == 0) GC[kch] = etot;
        __syncthreads();
        f32x4 oacc[2];
#pragma unroll
        for (int x = 0; x < 2; ++x) { const int id = 2 * wave + x, tm = id >> 2, tn = id & 3;
            f32x4 a = {0.f, 0.f, 0.f, 0.f}, o = {0.f, 0.f, 0.f, 0.f};
#pragma unroll
            for (int q = 0; q < 4; ++q) { const bf16x8 A = *(const bf16x8*)(QT + (tm * 16 + lr) * 136 + q * 32 + lq * 8);
                const bf16x8 Bk = *(const bf16x8*)(KT + (tn * 16 + lr) * 136 + q * 32 + lq * 8); const bf16x8 Bs = *(const bf16x8*)(ST + (tn * 16 + lr) * 136 + q * 32 + lq * 8);
                a = __builtin_amdgcn_mfma_f32_16x16x32_bf16(A, Bk, a, 0, 0, 0); o = __builtin_amdgcn_mfma_f32_16x16x32_bf16(A, Bs, o, 0, 0, 0); }
#pragma unroll
            for (int j = 0; j < 4; ++j) { const int trow = tm * 16 + lq * 4 + j, scol = tn * 16 + lr; AM[trow * 72 + scol] = f2bf(scol <= trow ? a[j] : 0.f); }
            oacc[x] = o; }
        __syncthreads();
#pragma unroll
        for (int x = 0; x < 2; ++x) { const int id = 2 * wave + x, tm = id >> 2, tn = id & 3;
#pragma unroll
            for (int q = 0; q < 2; ++q) { const bf16x8 A = *(const bf16x8*)(AM + (tm * 16 + lr) * 72 + q * 32 + lq * 8); const bf16x8 B = *(const bf16x8*)(VT + (tn * 16 + lr) * 72 + q * 32 + lq * 8);
                oacc[x] = __builtin_amdgcn_mfma_f32_16x16x32_bf16(A, B, oacc[x], 0, 0, 0); }
#pragma unroll
            for (int j = 0; j < 4; ++j) { const int i = tm * 16 + lq * 4 + j; const int step = c * 64 + i, t = d ? T - 1 - step : step;
                OB[(size_t)(g0 + t) * 512 + 128 * h + 64 * vh + tn * 16 + lr] = f2bf(oacc[x][j]); } }
#pragma unroll
        for (int x = 0; x < 4; ++x) { const int id = 4 * wave + x, tv = id >> 3, tk = id & 7; const float gc = GC[tk * 16 + lr];
            sacc[x] = sacc[x] * gc;
#pragma unroll
            for (int q = 0; q < 2; ++q) { const bf16x8 A = *(const bf16x8*)(VT + (tv * 16 + lr) * 72 + q * 32 + lq * 8); const bf16x8 B = *(const bf16x8*)(KH + (tk * 16 + lr) * 72 + q * 32 + lq * 8);
                sacc[x] = __builtin_amdgcn_mfma_f32_16x16x32_bf16(A, B, sacc[x], 0, 0, 0); }
#pragma unroll
            for (int j = 0; j < 4; ++j) ST[(tv * 16 + lq * 4 + j) * 136 + tk * 16 + lr] = f2bf(sacc[x][j]); }
        __syncthreads();
    }
    if (!grid) {
#pragma unroll
        for (int x = 0; x < 4; ++x) { const int id = 4 * wave + x, tv = id >> 3, tk = id & 7;
#pragma unroll
            for (int j = 0; j < 4; ++j) { const int v = tv * 16 + lq * 4 + j, k = tk * 16 + lr;
                p.out[OUT_SB + ((size_t)((bidx * 2 + d) * 4 + h) * 128 + k) * 128 + 64 * vh + v] = sacc[x][j]; } }
    }
    __syncthreads();
}

__device__ __forceinline__ void phase4(const Params& p, unsigned char* smem, int mode = 0) {
    const int G = gridDim.x, b = blockIdx.x;
    const bool fast = (G == 256);
    const int n_it = fast ? (b < 128 ? 1 : 5) : (768 - b + G - 1) / G;
    for (int n = 0; n < n_it; ++n) {
        const int it = fast ? (n == 0 ? b : 256 + (b - 128) + 128 * (n - 1)) : (b + n * G);
        if ((mode == 1 && it >= 128) || (mode == 2 && it < 128) || (mode == 3 && !(it >= 128 && it < 256))) continue;
        if (it < 128) rwkv_item(p, smem, 16 + (it >> 4), (it >> 3) & 1, it & 7);
        else if (it < 256) { const int j = it - 128; hgrn_item(p, smem, 16 + (j >> 4), (j >> 3) & 1, (j >> 1) & 3, j & 1); }
        else if (it < 512) { const int q = it - 256; rwkv_item(p, smem, q >> 4, (q >> 3) & 1, q & 7, fast && n == 2); }
        else { const int q2 = it - 512; hgrn_item(p, smem, q2 >> 4, (q2 >> 3) & 1, (q2 >> 1) & 3, q2 & 1); }
    }
}

__device__ __forceinline__ void phase5(const Params& p) {
    const int tid = otid(), lane = tid & 63, wave = tid >> 6;
    const int gw = blockIdx.x * 8 + wave, NGW = gridDim.x * 8;
    const bf16_t* YA0 = p.pa; const bf16_t* YA1 = YA0 + (size_t)NTOK * 512;
    const bf16_t* OB0 = YA0 + (size_t)NTOK * 1024; const bf16_t* OB1 = OB0 + (size_t)NTOK * 512;
    bf16_t* mix = p.xm;
    const int c8 = 8 * lane;
    float lw[8], lb8[8], og[8];
    ld8f(p.lnx_w + c8, lw); ld8f(p.lnx_b + c8, lb8); ld8f(p.onorm_g + c8, og);
    for (int tok = gw; tok < NTOK; tok += NGW) {
        const u32x4 ya0 = *(const u32x4*)(YA0 + (size_t)tok * 512 + c8), ya1 = *(const u32x4*)(YA1 + (size_t)tok * 512 + c8);
        const u32x4 ob0 = *(const u32x4*)(OB0 + (size_t)tok * 512 + c8), ob1 = *(const u32x4*)(OB1 + (size_t)tok * 512 + c8);
        const u32x4 v_c = *(const u32x4*)((const bf16_t*)p.out + (size_t)tok * 1792 + 1024 + c8), z_c = *(const u32x4*)(p.zs + (size_t)tok * 512 + c8);
        const u32x4 zb4 = *(const u32x4*)(p.pb + (size_t)tok * 2560 + 2048 + c8);
        const int hA = lane >> 3;
        const float bonus = p.bon[(size_t)tok * 8 + hA] + p.bon[(size_t)NTOK * 8 + (size_t)tok * 8 + hA];
        float y[8], tmp[8], vv[8], zz[8];
        unpack8(ya0, y); unpack8(ya1, tmp);
        float s = 0.f;
#pragma unroll
        for (int j = 0; j < 8; ++j) { y[j] += tmp[j]; s += y[j]; }
        const float mean = red8(s) * (1.f / 64.f);
        float q = 0.f;
#pragma unroll
        for (int j = 0; j < 8; ++j) { y[j] -= mean; q += y[j] * y[j]; }
        const float rstd = rsqrtf(red8(q) * (1.f / 64.f) + 64e-5f);
        unpack8(v_c, vv); unpack8(z_c, zz);
        float o[8];
#pragma unroll
        for (int j = 0; j < 8; ++j) o[j] = (y[j] * rstd * lw[j] + lb8[j] + bonus * vv[j]) * zz[j];
        { u32x4 w; w.x = cvt_pk_bf16(o[0], o[1]); w.y = cvt_pk_bf16(o[2], o[3]); w.z = cvt_pk_bf16(o[4], o[5]); w.w = cvt_pk_bf16(o[6], o[7]); *(u32x4*)(mix + (size_t)tok * 1024 + c8) = w; }
        unpack8(ob0, y); unpack8(ob1, tmp); unpack8(zb4, zz);
        float ss = 0.f;
#pragma unroll
        for (int j = 0; j < 8; ++j) { y[j] += tmp[j]; ss += y[j] * y[j]; }
        const float rs = rsqrtf(red16(ss) * (1.f / 128.f) + 1e-6f);
#pragma unroll
        for (int j = 0; j < 8; ++j) o[j] = y[j] * rs * og[j] * (zz[j] * sigmoidf_(zz[j]));
        { u32x4 w; w.x = cvt_pk_bf16(o[0], o[1]); w.y = cvt_pk_bf16(o[2], o[3]); w.z = cvt_pk_bf16(o[4], o[5]); w.w = cvt_pk_bf16(o[6], o[7]); *(u32x4*)(mix + (size_t)tok * 1024 + 512 + c8) = w; }
    }
}

__device__ __forceinline__ void phase7(const Params& p) {
    const int tid = otid(), lane = tid & 63, wave = tid >> 6;
    const int gw = blockIdx.x * 8 + wave, NGW = gridDim.x * 8;
    const bool split = (gridDim.x == 256);
    float ga[8], gb[8]; ld8f(p.final_g + 8 * lane, ga); ld8f(p.final_g + 512 + 8 * lane, gb);
    for (int tok = gw; tok < NTOK; tok += 2 * NGW) {
        const bool two = (tok + NGW) < NTOK; const int tokb = two ? tok + NGW : tok;
        const bf16_t* ha = p.pb + (size_t)tok * 1024; const bf16_t* hb = p.pb + (size_t)tokb * 1024;
        const u32x4 a0 = *(const u32x4*)(ha + 8 * lane), a1 = *(const u32x4*)(ha + 512 + 8 * lane), b0 = *(const u32x4*)(hb + 8 * lane), b1 = *(const u32x4*)(hb + 512 + 8 * lane);
        float xa0[8], xa1[8], xb0[8], xb1[8]; unpack8(a0, xa0); unpack8(a1, xa1); unpack8(b0, xb0); unpack8(b1, xb1);
        if (split) {
            if (tok >= 16384) { const bf16_t* q = p.pa + (size_t)(tok - 16384) * 1024; float t0[8], t1[8]; unpack8(*(const u32x4*)(q + 8 * lane), t0); unpack8(*(const u32x4*)(q + 512 + 8 * lane), t1);
#pragma unroll
                for (int j = 0; j < 8; ++j) { xa0[j] += t0[j]; xa1[j] += t1[j]; } }
            if (tokb >= 16384) { const bf16_t* q = p.pa + (size_t)(tokb - 16384) * 1024; float t0[8], t1[8]; unpack8(*(const u32x4*)(q + 8 * lane), t0); unpack8(*(const u32x4*)(q + 512 + 8 * lane), t1);
#pragma unroll
                for (int j = 0; j < 8; ++j) { xb0[j] += t0[j]; xb1[j] += t1[j]; } }
        }
        float sa = 0.f, sb = 0.f;
#pragma unroll
        for (int j = 0; j < 8; ++j) { sa += xa0[j] * xa0[j] + xa1[j] * xa1[j]; sb += xb0[j] * xb0[j] + xb1[j] * xb1[j]; }
        sa = wave_sum_fast(sa); sb = wave_sum_fast(sb);
        const float ra = rsqrtf(sa * (1.f / 1024.f) + 1e-6f), rb = rsqrtf(sb * (1.f / 1024.f) + 1e-6f);
        float* ya = p.out + (size_t)tok * 1024; float* yb = p.out + (size_t)tokb * 1024;
        *(float4*)(ya + 8 * lane) = make_float4(xa0[0] * ra * ga[0], xa0[1] * ra * ga[1], xa0[2] * ra * ga[2], xa0[3] * ra * ga[3]);
        *(float4*)(ya + 8 * lane + 4) = make_float4(xa0[4] * ra * ga[4], xa0[5] * ra * ga[5], xa0[6] * ra * ga[6], xa0[7] * ra * ga[7]);
        *(float4*)(ya + 512 + 8 * lane) = make_float4(xa1[0] * ra * gb[0], xa1[1] * ra * gb[1], xa1[2] * ra * gb[2], xa1[3] * ra * gb[3]);
        *(float4*)(ya + 512 + 8 * lane + 4) = make_float4(xa1[4] * ra * gb[4], xa1[5] * ra * gb[5], xa1[6] * ra * gb[6], xa1[7] * ra * gb[7]);
        if (two) {
            *(float4*)(yb + 8 * lane) = make_float4(xb0[0] * rb * ga[0], xb0[1] * rb * ga[1], xb0[2] * rb * ga[2], xb0[3] * rb * ga[3]);
            *(float4*)(yb + 8 * lane + 4) = make_float4(xb0[4] * rb * ga[4], xb0[5] * rb * ga[5], xb0[6] * rb * ga[6], xb0[7] * rb * ga[7]);
            *(float4*)(yb + 512 + 8 * lane) = make_float4(xb1[0] * rb * gb[0], xb1[1] * rb * gb[1], xb1[2] * rb * gb[2], xb1[3] * rb * gb[3]);
            *(float4*)(yb + 512 + 8 * lane + 4) = make_float4(xb1[4] * rb * gb[4], xb1[5] * rb * gb[5], xb1[6] * rb * gb[6], xb1[7] * rb * gb[7]);
        }
    }
}

#define XB_TMO      128
#define XB_XCNT(j)  (256  + 64 * (j))
#define XB_XSUB(j)  (1280 + 64 * (j))
#define XB_XGEN(j)  (2304 + 64 * (j))
#define XB_TOP      3328
#define XB_TOPGEN   3392
#define XCD_BAR_WORDS 3456
#define XB_SPIN_CAP (1u << 18)
#define XLAS __attribute__((address_space(3)))

__device__ __forceinline__ unsigned xb_ld(unsigned* p)              { return __hip_atomic_load(p, __ATOMIC_RELAXED, __HIP_MEMORY_SCOPE_AGENT); }
__device__ __forceinline__ unsigned xb_add(unsigned* p, unsigned v) { return __hip_atomic_fetch_add(p, v, __ATOMIC_RELAXED, __HIP_MEMORY_SCOPE_AGENT); }
__device__ __forceinline__ unsigned xb_xcc_id() { return (unsigned)__builtin_amdgcn_s_getreg((3 << 11) | 20) & 0xFu; }
#define XB_SPIN(cond, bar) do { unsigned _sp = 0; while (cond) { __builtin_amdgcn_s_sleep(1); \
    if ((++_sp & 255u) == 0u) { if (xb_ld(&(bar)[XB_TMO])) break; if (_sp > XB_SPIN_CAP) { atomicAdd(&(bar)[XB_TMO], 1u); break; } } } } while (0)

struct XcdBarrier {
    unsigned* bar; unsigned x;
    volatile XLAS unsigned* st;
};

__device__ __forceinline__ XcdBarrier xcd_barrier_post(unsigned* bar, volatile XLAS unsigned* st) {
    XcdBarrier b; b.bar = bar; b.x = xb_xcc_id(); b.st = st;
    if (threadIdx.x == 0) (void)xb_add(&bar[XB_XCNT(b.x)], 1u);
    return b;
}
__device__ __forceinline__ void xcd_barrier_complete(unsigned* bar, unsigned x, unsigned& nloc, unsigned& nx) {
    const unsigned G = gridDim.x * gridDim.y * gridDim.z;
    unsigned sum, cnt, mine, sp = 0u;
    for (;;) {
        sum = 0u; cnt = 0u; mine = 0u;
#pragma unroll
        for (unsigned j = 0; j < 16; ++j) { const unsigned c = xb_ld(&bar[XB_XCNT(j)]); sum += c; cnt += (c > 0u) ? 1u : 0u; mine = (j == x) ? c : mine; }
        if (sum == G) break;
        __builtin_amdgcn_s_sleep(1);
        if ((++sp & 255u) == 0u) { if (xb_ld(&bar[XB_TMO])) break; if (sp > XB_SPIN_CAP) { atomicAdd(&bar[XB_TMO], 1u); break; } }
    }
    nloc = mine > 0u ? mine : 1u; nx = cnt > 0u ? cnt : 1u;
}

__device__ __forceinline__ void xcd_barrier(const XcdBarrier& b) {
    asm volatile("s_waitcnt vmcnt(0)" ::: "memory");
    __syncthreads();
    if (threadIdx.x == 0) {
        unsigned* bar = b.bar;
        __builtin_amdgcn_s_waitcnt(0);
        unsigned nloc = b.st[0], nx = b.st[1];
        if (nloc == 0u) { xcd_barrier_complete(bar, b.x, nloc, nx); b.st[0] = nloc; b.st[1] = nx; }
        const unsigned old = xb_add(&bar[XB_XSUB(b.x)], 1u);
        const unsigned gen = old / nloc;
        if (old + 1u == (gen + 1u) * nloc) {
            __builtin_amdgcn_fence(__ATOMIC_RELEASE, "agent");
            asm volatile("s_waitcnt vmcnt(0)" ::: "memory");
            const unsigned og = xb_add(&bar[XB_TOP], 1u);
            const unsigned tg = og / nx;
            if (og + 1u == (tg + 1u) * nx) xb_add(&bar[XB_TOPGEN], 1u);
            else XB_SPIN(xb_ld(&bar[XB_TOPGEN]) == tg, bar);
            __builtin_amdgcn_fence(__ATOMIC_ACQUIRE, "agent");
            xb_add(&bar[XB_XGEN(b.x)], 1u);
            asm volatile("s_waitcnt vmcnt(0)" ::: "memory");
        } else {
            XB_SPIN(xb_ld(&bar[XB_XGEN(b.x)]) == gen, bar);
            __builtin_amdgcn_fence(__ATOMIC_ACQUIRE, "agent");
            asm volatile("s_waitcnt vmcnt(0)" ::: "memory");
        }
    }
    __syncthreads();
}


__device__ __forceinline__ void gsync(cg::grid_group& g) {
    asm volatile("s_waitcnt vmcnt(0) lgkmcnt(0)" ::: "memory");
    g.sync();
    if (threadIdx.x < 64) { __builtin_amdgcn_fence(__ATOMIC_ACQUIRE, "agent"); asm volatile("s_waitcnt vmcnt(0)" ::: "memory"); }
    __syncthreads();
}
__global__ __launch_bounds__(512, 2) void fwd_megakernel(Params p) {
    extern __shared__ __attribute__((aligned(16))) unsigned char shm[];
    cg::grid_group grid = cg::this_grid();
    volatile XLAS unsigned* xst = (volatile XLAS unsigned*)(shm + LDS_BYTES - 16);
    if (threadIdx.x == 0) { xst[0] = 0u; xst[1] = 0u; }
    __syncthreads();
    const XcdBarrier xb = xcd_barrier_post(p.bar, xst);
    bool dup_done = false; (void)dup_done;
    for (int ph = p.ph_lo; ph < p.ph_hi; ++ph) {
        if (ph == 0) phase0(p, shm);
        else if (ph == 1) phase1(p, shm);
        else if (ph == 2) { pg8::StaticOrder S; S.init(NTOK, 4864, (int)gridDim.x, (int)blockIdx.x); pg8::Gemm g{p.xm, p.wt_in, NTOK, 4864, 1024, 1024}; pg8::EpiP E{p.pa, p.pb, p.lb_logits};
            pg8::gemm_phase<pg8::EpiP, pg8::StaticOrder>((PG8_LAS unsigned char*)shm, g, S, E); }
        else if (ph == 3) phase3(p);
#ifdef P4MODE
        else if (ph == 4) phase4(p, shm, dup_done ? P4MODE : 0);
#else
        else if (ph == 4) phase4(p, shm);
#endif
        else if (ph == 5) phase5(p);
        else if (ph == 6) {
            if (gridDim.x == 256) {
                const int b = blockIdx.x;
                { pg8::OrderOne S{8 * (b & 7) + (b >> 5), (b >> 3) & 3, true}; pg8::Gemm g{p.xm, p.wt_out, NTOK, 1024, 1024, 1024}; pg8::EpiH E{p.x_prompt, p.x_sample, p.gate, p.pb, p.pa, 0};
                  pg8::gemm_phase<pg8::EpiH, pg8::OrderOne>((PG8_LAS unsigned char*)shm, g, S, E); }
                { const int u2 = b >> 1, half = b & 1; pg8::OrderOne S{64 + (u2 >> 2), u2 & 3, b < 128};
                  pg8::Gemm g{p.xm + 512 * half, p.wt_out + 512 * half, NTOK, 1024, 512, 1024}; pg8::EpiH E{p.x_prompt, p.x_sample, p.gate, p.pb, p.pa, half};
                  pg8::gemm_phase<pg8::EpiH, pg8::OrderOne>((PG8_LAS unsigned char*)shm, g, S, E); }
            } else { pg8::StaticOrder S; S.init(NTOK, 1024, (int)gridDim.x, (int)blockIdx.x); pg8::Gemm g{p.xm, p.wt_out, NTOK, 1024, 1024, 1024}; pg8::EpiH E{p.x_prompt, p.x_sample, p.gate, p.pb, p.pa, 0};
                pg8::gemm_phase<pg8::EpiH, pg8::StaticOrder>((PG8_LAS unsigned char*)shm, g, S, E); }
        }
        else phase7(p);
        if (ph + 1 < p.ph_hi) { if (p.ph_lo < 0) gsync(grid); else xcd_barrier(xb); }
#ifdef DUPPH
        if (ph == DUPPH && !dup_done) { dup_done = true; --ph; }
#endif
    }
}

#ifndef NLAUNCH
#define NLAUNCH 1
#endif
extern "C" void kernel_launch(void* const* d_in, const int* in_sizes, int n_in, void* d_out, int out_size, void* d_ws, size_t ws_size, hipStream_t stream) {
    static int grid_blocks = 0;
    if (grid_blocks == 0) {
        if (n_in != 25 || ws_size < WS_END) { fprintf(stderr, "kernel_launch: unexpected n_in %d / ws %zu (need %zu)\n", n_in, ws_size, (size_t)WS_END); grid_blocks = -1; return; }
        int dev = 0, cus = 0, per_cu = 0;
        hipGetDevice(&dev);
        hipDeviceGetAttribute(&cus, hipDeviceAttributeMultiprocessorCount, dev);
        hipFuncSetAttribute((const void*)fwd_megakernel, hipFuncAttributeMaxDynamicSharedMemorySize, LDS_BYTES);
        hipOccupancyMaxActiveBlocksPerMultiprocessor(&per_cu, (const void*)fwd_megakernel, 512, LDS_BYTES);
        if (per_cu < 1) { fprintf(stderr, "kernel_launch: occupancy query says %d blocks per CU\n", per_cu); grid_blocks = -1; return; }
        grid_blocks = cus;
    }
    if (grid_blocks < 0) return;
    Params p{};
    const float* const* in = (const float* const*)d_in;
    p.x_prompt = in[0]; p.x_sample = in[1]; p.state_rwkv = in[2]; p.state_hgrn = in[3]; p.c = in[4]; p.c_ctx = in[5]; p.norm_g = in[6]; p.w_ada = in[7]; p.b_ada = in[8]; p.w_in = in[9];
    p.mu_h = in[10]; p.mu_v = in[11]; p.w0 = in[12]; p.w2 = in[13]; p.a0 = in[14]; p.a2 = in[15]; p.k_k = in[16]; p.k_a = in[17]; p.r_k = in[18]; p.lnx_w = in[19]; p.lnx_b = in[20];
    p.lb_logits = in[21]; p.onorm_g = in[22]; p.w_out = in[23]; p.final_g = in[24];
    p.out = (float*)d_out;
    unsigned char* ws = (unsigned char*)d_ws;
    p.modp = (float*)(ws + WS_MODP); p.gate = (float*)(ws + WS_GATE); p.bon = (float*)(ws + WS_BON); p.wt_in = (bf16_t*)(ws + WS_WTIN); p.wt_out = (bf16_t*)(ws + WS_WTOUT);
    p.xm = (bf16_t*)(ws + WS_XM); p.pa = (bf16_t*)(ws + WS_PA); p.pb = (bf16_t*)(ws + WS_PB); p.zs = (bf16_t*)(ws + WS_WTIN);
    p.bar = (unsigned*)(ws + WS_BAR);
    hipMemsetAsync(ws + WS_BAR, 0, XCD_BAR_WORDS * sizeof(unsigned), stream);
#if NLAUNCH == 1
    p.ph_lo = 0; p.ph_hi = 8;
    void* args[] = {&p};
    hipError_t e = hipLaunchCooperativeKernel((const void*)fwd_megakernel, dim3(grid_blocks), dim3(512), args, LDS_BYTES, stream);
    if (e != hipSuccess) fprintf(stderr, "cooperative launch failed: %s (grid %d)\n", hipGetErrorString(e), grid_blocks);
#else
    for (int ph = 0; ph < 8; ++ph) { p.ph_lo = ph; p.ph_hi = ph + 1; hipLaunchKernelGGL(fwd_megakernel, dim3(grid_blocks), dim3(512), LDS_BYTES, stream, p); }
#endif
}
```

```cpp
#include <hip/hip_runtime.h>
#include <hip/hip_cooperative_groups.h>
#include <cstdio>
#include <cstdint>
namespace cg = cooperative_groups;

namespace pg8 {
#define PG8_LAS __attribute__((address_space(3)))
typedef unsigned short bf16_t;
typedef short bf16x8 __attribute__((ext_vector_type(8)));
typedef float f32x4 __attribute__((ext_vector_type(4)));
typedef unsigned u32x4 __attribute__((ext_vector_type(4)));
constexpr int BM = 256, BK = 64, HALF = 128, HTB = HALF * BK * 2, STAGE_BYTES = 8 * HTB, NXCD = 8, WGM = 8;

__host__ __device__ __forceinline__ int lds_byte(int r, int c) { const int st = (r >> 4) * 2 + (c >> 5), rr = r & 15, cc = c & 31, ob = rr * 64 + cc * 2; return st * 1024 + (ob ^ (((ob >> 9) & 1) << 5)); }
__host__ __device__ __forceinline__ void stage_rc(int b, int& R, int& C) { const int st = b / 1024, sb = b % 1024, swz = sb ^ (((sb >> 9) & 1) << 5); R = (st >> 1) * 16 + swz / 64; C = (st & 1) * 32 + (swz % 64) / 2; }
__host__ __device__ __forceinline__ int perm32(int rho) { const int n = rho >> 4, i = rho & 15; return 8 * (i >> 2) + 4 * n + (i & 3); }

struct Unit { int pm, pn; };
struct Gemm { const bf16_t* A; const bf16_t* Bt; int M, N, K, ld; };

struct StaticOrder {
    int nM, nN, nwg, G, c;
    __host__ __device__ void init(int M, int N, int G_, int c_) { nM = M / BM; nN = N / BM; nwg = nM * nN; G = G_; c = c_; }
    __host__ __device__ bool next(int i, Unit& u) const {
        const long L = (long)i * G + c; if (L >= nwg) return false;
        int wgid = (int)L; { const int q = nwg / NXCD, r = nwg % NXCD, xcd = wgid % NXCD, off = wgid / NXCD; wgid = (xcd < r ? xcd * (q + 1) : r * (q + 1) + (xcd - r) * q) + off; }
        const int nig = WGM * nN, gid = wgid / nig, fm = gid * WGM, gsz = (nM - fm) < WGM ? (nM - fm) : WGM;
        u.pm = fm + ((wgid % nig) % gsz); u.pn = (wgid % nig) / gsz; return true;
    }
    __device__ __forceinline__ void a_ready(const Unit&) const {}
    __device__ __forceinline__ void done(const Unit&) const {}
};

typedef __bf16 bf16x2_t __attribute__((ext_vector_type(2)));
typedef float f32x2_t __attribute__((ext_vector_type(2)));
struct OrderOne { int pm, pn; bool on;
    __device__ __forceinline__ bool next(int i, Unit& u) const { if (i > 0 || !on) return false; u.pm = pm; u.pn = pn; return true; }
    __device__ __forceinline__ void a_ready(const Unit&) const {}
    __device__ __forceinline__ void done(const Unit&) const {}
};
__device__ __forceinline__ unsigned cvt_pk_bf16(float lo, float hi) { const f32x2_t v = {lo, hi}; return __builtin_bit_cast(unsigned, __builtin_convertvector(v, bf16x2_t)); }

struct EpiP {
    static constexpr bool PERM = true, AFTER_DRAIN = false;
    bf16_t* pa; bf16_t* pb; const float* lbl;
    __device__ __forceinline__ void operator()(const f32x4 (&acc)[2][2][4][2], const Unit& u, int wr, int wc, int fr, int fq) const {
        const int row0 = u.pm * BM + wr * 64 + fr;
        bf16_t* base; int ldc, colt;
        if (u.pn < 9) { base = pa; ldc = 2304; colt = u.pn * BM; } else { base = pb; ldc = 2560; colt = (u.pn - 9) * BM; }
        const int col0 = colt + wc * 32 + 8 * fq;
        const int ct = u.pn - 9;
        const int kind = (ct < 0) ? 0 : ((ct < 2) ? 1 : ((ct >= 4 && ct < 8) ? 2 : 0));
        float lbv[2][8];
#pragma unroll
        for (int bj = 0; bj < 2; ++bj)
#pragma unroll
            for (int j = 0; j < 8; ++j) lbv[bj][j] = 0.f;
        if (kind == 2) { const int d = (ct - 4) >> 1, cb = (ct & 1) * 256 + wc * 32 + 8 * fq;
#pragma unroll
            for (int bj = 0; bj < 2; ++bj)
#pragma unroll
                for (int j = 0; j < 8; ++j) { const int c = cb + bj * HALF + j; const float l0 = lbl[(0 * 2 + d) * 512 + c], l1 = lbl[(1 * 2 + d) * 512 + c]; lbv[bj][j] = __builtin_amdgcn_rcpf(1.f + __expf(l1 - l0)); } }
#pragma unroll
        for (int ai = 0; ai < 2; ++ai)
#pragma unroll
            for (int m = 0; m < 4; ++m) { bf16_t* rowp = base + (size_t)(row0 + ai * HALF + m * 16) * ldc + col0;
#pragma unroll
                for (int bj = 0; bj < 2; ++bj) { f32x4 v0 = acc[ai][bj][m][0], v1 = acc[ai][bj][m][1];
                    if (kind == 1) {
#pragma unroll
                        for (int j = 0; j < 4; ++j) { v0[j] = v0[j] * __builtin_amdgcn_rcpf(1.f + __expf(-v0[j])); v1[j] = v1[j] * __builtin_amdgcn_rcpf(1.f + __expf(-v1[j])); } }
                    else if (kind == 2) {
#pragma unroll
                        for (int j = 0; j < 4; ++j) { const float la = lbv[bj][j], lb2 = lbv[bj][4 + j];
                            v0[j] = __logf(la + (1.f - la) * __builtin_amdgcn_rcpf(1.f + __expf(-v0[j]))); v1[j] = __logf(lb2 + (1.f - lb2) * __builtin_amdgcn_rcpf(1.f + __expf(-v1[j]))); } }
                    u32x4 w; w.x = cvt_pk_bf16(v0[0], v0[1]); w.y = cvt_pk_bf16(v0[2], v0[3]); w.z = cvt_pk_bf16(v1[0], v1[1]); w.w = cvt_pk_bf16(v1[2], v1[3]);
                    *(u32x4*)(rowp + bj * HALF) = w; } }
    }
};
struct EpiH {
    static constexpr bool PERM = false, AFTER_DRAIN = false;
    const float* xp; const float* xs; const float* gate; bf16_t* hb; bf16_t* h2; int part;
    __device__ __forceinline__ void operator()(const f32x4 (&acc)[2][2][4][2], const Unit& u, int wr, int wc, int fr, int fq) const {
        const int row0 = u.pm * BM + wr * 64 + fr, col0 = u.pn * BM + wc * 32 + 4 * fq;
        const int modrow = (u.pm < 16) ? 0 : 1 + ((u.pm - 16) >> 3);
        f32x4 gv[2][2];
#pragma unroll
        for (int bj = 0; bj < 2; ++bj)
#pragma unroll
            for (int n = 0; n < 2; ++n) gv[bj][n] = *(const f32x4*)(gate + modrow * 1024 + col0 + bj * HALF + n * 16);
        f32x4 xb[2][2][2];
#pragma unroll
        for (int q = 0; q < 2; ++q)
#pragma unroll
            for (int bj = 0; bj < 2; ++bj)
#pragma unroll
                for (int n = 0; n < 2; ++n) xb[q][bj][n] = (f32x4){0.f, 0.f, 0.f, 0.f};
        if (!part) { const float* xrow = (u.pm < 16) ? xp + (size_t)row0 * 1024 : xs + (size_t)(row0 - 4096) * 1024;
#pragma unroll
            for (int bj = 0; bj < 2; ++bj)
#pragma unroll
                for (int n = 0; n < 2; ++n) xb[0][bj][n] = *(const f32x4*)(xrow + col0 + bj * HALF + n * 16); }
#pragma unroll
        for (int idx = 0; idx < 8; ++idx) { const int ai = idx >> 2, m = idx & 3; const int r = row0 + ai * HALF + m * 16;
            if (!part && idx + 1 < 8) { const int rn = row0 + ((idx + 1) >> 2) * HALF + ((idx + 1) & 3) * 16;
                const float* xrow = (u.pm < 16) ? xp + (size_t)rn * 1024 : xs + (size_t)(rn - 4096) * 1024;
#pragma unroll
                for (int bj = 0; bj < 2; ++bj)
#pragma unroll
                    for (int n = 0; n < 2; ++n) xb[(idx + 1) & 1][bj][n] = *(const f32x4*)(xrow + col0 + bj * HALF + n * 16); }
            bf16_t* orow = part ? h2 + (size_t)(r - 16384) * 1024 : hb + (size_t)r * 1024;
#pragma unroll
            for (int bj = 0; bj < 2; ++bj)
#pragma unroll
                for (int n = 0; n < 2; ++n) { const int c = col0 + bj * HALF + n * 16; const f32x4 hv = gv[bj][n] * acc[ai][bj][m][n] + xb[idx & 1][bj][n];
                    uint2 o; o.x = cvt_pk_bf16(hv[0], hv[1]); o.y = cvt_pk_bf16(hv[2], hv[3]); *(uint2*)(orow + c) = o; } }
    }
};

template <class Epi, class Sched>
__device__ __forceinline__ void gemm_phase(PG8_LAS unsigned char* lds, const Gemm g, const Sched& S, const Epi& E) {
    int tid = threadIdx.x; asm volatile("" : "+v"(tid)); const int wid = __builtin_amdgcn_readfirstlane(tid >> 6), lane = tid & 63, wr = wid >> 2, wc = wid & 3, fr = lane & 15, fq = lane >> 4;
    const int K = g.K, nt = K / BK, ld = g.ld;
    unsigned voffA[2], voffB[2];
#pragma unroll
    for (int i = 0; i < 2; ++i) { int R, C; stage_rc(tid * 16 + i * 8192, R, C); const int Rb = Epi::PERM ? ((R & ~31) + perm32(R & 31)) : R;
        voffA[i] = (unsigned)(R * ld + C) * 2u; voffB[i] = (unsigned)(Rb * ld + C) * 2u; }
    const size_t kstep = (size_t)(BK * 2);
    const size_t hstep = (size_t)HALF * ld * 2;
    const size_t tstep = 2 * hstep;
    const unsigned ldsw = (unsigned)wid * 1024u;
    const int aoff = lds_byte(wr * 64 + fr, fq * 8), boff = lds_byte(wc * 32 + fr, fq * 8);
#define PG8_SA(b, h) (((b) * 2 + (h)) * HTB)
#define PG8_SB(b, h) ((4 + (b) * 2 + (h)) * HTB)
#define PG8_STAGE(bufoff, gbase, voff) do { _Pragma("unroll") for (int _i = 0; _i < 2; ++_i) \
        __builtin_amdgcn_global_load_lds((const unsigned*)((const char*)(gbase) + (voff)[_i]), (PG8_LAS unsigned*)(lds + (bufoff) + ldsw + _i * 8192), 16, 0, 0); } while (0)
#define PG8_LDA(dst, b, h) do { _Pragma("unroll") for (int m = 0; m < 4; ++m) _Pragma("unroll") for (int k = 0; k < 2; ++k) dst[m][k] = *(const PG8_LAS bf16x8*)(lds + PG8_SA(b, h) + aoff + m * 2048 + k * 1024); } while (0)
#define PG8_LDB(dst, b, h) do { _Pragma("unroll") for (int n = 0; n < 2; ++n) _Pragma("unroll") for (int k = 0; k < 2; ++k) dst[n][k] = *(const PG8_LAS bf16x8*)(lds + PG8_SB(b, h) + boff + n * 2048 + k * 1024); } while (0)
#define PG8_MMA(ai, bj, At, Bt) do { __builtin_amdgcn_s_setprio(1); _Pragma("unroll") for (int m = 0; m < 4; ++m) _Pragma("unroll") for (int n = 0; n < 2; ++n) _Pragma("unroll") for (int k = 0; k < 2; ++k) \
        acc[ai][bj][m][n] = __builtin_amdgcn_mfma_f32_16x16x32_bf16(Bt[n][k], At[m][k], acc[ai][bj][m][n], 0, 0, 0); __builtin_amdgcn_s_setprio(0); } while (0)
#define PG8_WAIT_V(n) asm volatile("s_waitcnt vmcnt(" #n ")" ::: "memory")
#define PG8_WAIT_L(n) asm volatile("s_waitcnt lgkmcnt(" #n ")" ::: "memory")
#define PG8_BAR __builtin_amdgcn_s_barrier()
#define PG8_SCHED __builtin_amdgcn_sched_barrier(0)
    Unit cur, nxt; int ui = 0;
    if (!S.next(0, cur)) return;
    f32x4 acc[2][2][4][2];
#pragma unroll
    for (int a = 0; a < 2; ++a)
#pragma unroll
        for (int b = 0; b < 2; ++b)
#pragma unroll
            for (int m = 0; m < 4; ++m)
#pragma unroll
                for (int n = 0; n < 2; ++n) acc[a][b][m][n] = (f32x4){0.f, 0.f, 0.f, 0.f};
    bf16x8 At[4][2], B0[2][2], B1[2][2];
    const char* cA = (const char*)g.A + (size_t)cur.pm * tstep; const char* cB = (const char*)g.Bt + (size_t)cur.pn * tstep;
    S.a_ready(cur);
    PG8_STAGE(PG8_SB(0, 0), cB, voffB); PG8_STAGE(PG8_SA(0, 0), cA, voffA); PG8_STAGE(PG8_SB(0, 1), cB + hstep, voffB); PG8_STAGE(PG8_SA(0, 1), cA + hstep, voffA);
    if (wr == 1) PG8_BAR;
    PG8_WAIT_V(4); PG8_BAR;
    PG8_STAGE(PG8_SB(1, 0), cB + kstep, voffB); PG8_STAGE(PG8_SA(1, 0), cA + kstep, voffA); PG8_STAGE(PG8_SB(1, 1), cB + hstep + kstep, voffB);
    PG8_WAIT_V(6); PG8_BAR;
    for (;;) {
        const bool has_next = S.next(ui + 1, nxt);
        const char* nA = has_next ? (const char*)g.A + (size_t)nxt.pm * tstep : cA; const char* nB = has_next ? (const char*)g.Bt + (size_t)nxt.pn * tstep : cB;
        for (int t = 0; t < nt; t += 2) {
            const bool last = (t == nt - 2);
            const char* a1 = cA + (size_t)(t + 1) * kstep;
            const char* a2 = last ? nA : cA + (size_t)(t + 2) * kstep; const char* b2 = last ? nB : cB + (size_t)(t + 2) * kstep;
            const char* a3 = a2 + kstep; const char* b3 = b2 + kstep;
            if (last && has_next) S.a_ready(nxt);
            PG8_LDB(B0, 0, 0); PG8_SCHED; PG8_LDA(At, 0, 0); PG8_STAGE(PG8_SA(1, 1), a1 + hstep, voffA);
            PG8_WAIT_L(8); PG8_BAR; PG8_WAIT_L(0); PG8_MMA(0, 0, At, B0); PG8_BAR; PG8_SCHED;
            PG8_LDB(B1, 0, 1); PG8_STAGE(PG8_SB(0, 0), b2, voffB);
            PG8_BAR; PG8_WAIT_L(0); PG8_MMA(0, 1, At, B1); PG8_BAR;
            PG8_LDA(At, 0, 1); PG8_STAGE(PG8_SA(0, 0), a2, voffA);
            PG8_BAR; PG8_WAIT_L(0); PG8_MMA(1, 0, At, B0); PG8_BAR; PG8_SCHED;
            PG8_STAGE(PG8_SB(0, 1), b2 + hstep, voffB);
            PG8_WAIT_V(6); PG8_BAR; PG8_MMA(1, 1, At, B1); PG8_BAR;
            PG8_LDB(B0, 1, 0); PG8_SCHED; PG8_LDA(At, 1, 0); PG8_STAGE(PG8_SA(0, 1), a2 + hstep, voffA);
            PG8_WAIT_L(8); PG8_BAR; PG8_WAIT_L(0); PG8_MMA(0, 0, At, B0); PG8_BAR; PG8_SCHED;
            PG8_LDB(B1, 1, 1); PG8_STAGE(PG8_SB(1, 0), b3, voffB);
            PG8_BAR; PG8_WAIT_L(0); PG8_MMA(0, 1, At, B1); PG8_BAR;
            PG8_LDA(At, 1, 1); PG8_STAGE(PG8_SA(1, 0), a3, voffA);
            PG8_BAR; PG8_WAIT_L(0); PG8_MMA(1, 0, At, B0); PG8_BAR; PG8_SCHED;
            PG8_STAGE(PG8_SB(1, 1), b3 + hstep, voffB);
            PG8_WAIT_V(6); PG8_BAR; PG8_MMA(1, 1, At, B1); PG8_BAR;
        }
        E(acc, cur, wr, wc, fr, fq); S.done(cur);
        if (!has_next) break;
#pragma unroll
        for (int a = 0; a < 2; ++a)
#pragma unroll
            for (int b = 0; b < 2; ++b)
#pragma unroll
                for (int m = 0; m < 4; ++m)
#pragma unroll
                    for (int n = 0; n < 2; ++n) acc[a][b][m][n] = (f32x4){0.f, 0.f, 0.f, 0.f};
        cur = nxt; cA = nA; cB = nB; ++ui;
    }
    PG8_WAIT_V(0);
    if (wr == 0) PG8_BAR;
    PG8_BAR;
#undef PG8_SA
#undef PG8_SB
#undef PG8_STAGE
#undef PG8_LDA
#undef PG8_LDB
#undef PG8_MMA
#undef PG8_WAIT_V
#undef PG8_WAIT_L
#undef PG8_BAR
#undef PG8_SCHED
}
}

using pg8::bf16_t; using pg8::bf16x8; using pg8::f32x4; using pg8::u32x4; using pg8::cvt_pk_bf16;

constexpr int NTOK = 20480, NPTOK = 4096;
constexpr int LDS_BYTES = 159744;
constexpr size_t OUT_Y = (size_t)NTOK * 1024;
constexpr size_t OUT_SA = OUT_Y;
constexpr size_t OUT_SB = OUT_Y + 1048576;
constexpr size_t WS_MODP = 0;
constexpr size_t WS_GATE = 884736;
constexpr size_t WS_BON = 921600;
constexpr size_t WS_WTOUT = 2359296;
constexpr size_t WS_XM = WS_WTOUT + 2097152;
constexpr size_t WS_PB = WS_XM + 41943040;
constexpr size_t WS_PA = WS_PB + 104857600;
constexpr size_t WS_WTIN = WS_PA + 94371840;
constexpr size_t WS_BAR = WS_WTIN + 20971520;
constexpr size_t WS_END = WS_BAR + 16384;

struct Params {
    const float *x_prompt, *x_sample, *state_rwkv, *state_hgrn, *c, *c_ctx, *norm_g, *w_ada, *b_ada, *w_in, *mu_h, *mu_v, *w0, *w2, *a0, *a2, *k_k, *k_a, *r_k,
                *lnx_w, *lnx_b, *lb_logits, *onorm_g, *w_out, *final_g;
    float* out;
    float* modp; float* gate; float* bon; bf16_t* wt_in; bf16_t* wt_out; bf16_t* xm; bf16_t* pa; bf16_t* pb; bf16_t* zs;
    unsigned* bar;
    int ph_lo, ph_hi;
};

__device__ __forceinline__ float bf2f(bf16_t h) { return __uint_as_float(((unsigned)h) << 16); }
__device__ __forceinline__ bf16_t f2bf(float f) { return __builtin_bit_cast(unsigned short, (__bf16)f); }
__device__ __forceinline__ float wave_sum(float v) {
#pragma unroll
    for (int o = 1; o < 64; o <<= 1) v += __shfl_xor(v, o);
    return v;
}
template <int CTRL> __device__ __forceinline__ float dppf(float x) { return __int_as_float(__builtin_amdgcn_update_dpp(0, __float_as_int(x), CTRL, 0xf, 0xf, true)); }
__device__ __forceinline__ float red8(float x) { x += dppf<0xB1>(x); x += dppf<0x4E>(x); x += dppf<0x141>(x); return x; }
__device__ __forceinline__ float red16(float x) { x = red8(x); x += dppf<0x140>(x); return x; }
__device__ __forceinline__ float wave_sum_fast(float x) {
    x = red16(x);
    const float a = __builtin_amdgcn_readlane(x, 0), b = __builtin_amdgcn_readlane(x, 16), c = __builtin_amdgcn_readlane(x, 32), d = __builtin_amdgcn_readlane(x, 48);
    return (a + b) + (c + d);
}
__device__ __forceinline__ float sigmoidf_(float x) { return __builtin_amdgcn_rcpf(1.f + __expf(-x)); }
__device__ __forceinline__ void unpack8(const u32x4 w, float* x) {
    x[0] = __uint_as_float(w.x << 16); x[1] = __uint_as_float(w.x & 0xffff0000u); x[2] = __uint_as_float(w.y << 16); x[3] = __uint_as_float(w.y & 0xffff0000u);
    x[4] = __uint_as_float(w.z << 16); x[5] = __uint_as_float(w.z & 0xffff0000u); x[6] = __uint_as_float(w.w << 16); x[7] = __uint_as_float(w.w & 0xffff0000u);
}
__device__ __forceinline__ int otid() { int t = threadIdx.x; asm volatile("" : "+v"(t)); return t; }
__device__ __forceinline__ void ld8f(const float* p, float* x) { const float4 a = *(const float4*)p, b = *(const float4*)(p + 4); x[0] = a.x; x[1] = a.y; x[2] = a.z; x[3] = a.w; x[4] = b.x; x[5] = b.y; x[6] = b.z; x[7] = b.w; }
__device__ __forceinline__ void lds_fence_wave() { asm volatile("s_waitcnt lgkmcnt(0)" ::: "memory"); __builtin_amdgcn_wave_barrier(); }

__device__ __forceinline__ void transpose_item(const float* __restrict__ W, int K, int N, bf16_t* __restrict__ WT, float* scr, int item, int lane) {
    const int nblk = N / 32, kb = item / nblk, nb = item % nblk, k0 = 64 * kb, n0 = 32 * nb;
#pragma unroll 8
    for (int i = 0; i < 32; ++i) { const int kk = 2 * i + (lane >> 5); scr[kk * 33 + (lane & 31)] = W[(size_t)(k0 + kk) * N + n0 + (lane & 31)]; }
    lds_fence_wave();
    const int c = lane & 7;
#pragma unroll
    for (int j = 0; j < 4; ++j) { const int n = (lane >> 3) + 8 * j; const float* s = scr + (8 * c) * 33 + n;
        u32x4 o; o.x = cvt_pk_bf16(s[0 * 33], s[1 * 33]); o.y = cvt_pk_bf16(s[2 * 33], s[3 * 33]); o.z = cvt_pk_bf16(s[4 * 33], s[5 * 33]); o.w = cvt_pk_bf16(s[6 * 33], s[7 * 33]);
        *(u32x4*)(WT + (size_t)(n0 + n) * K + k0 + 8 * c) = o; }
    lds_fence_wave();
}

__device__ __forceinline__ void phase0(const Params& p, unsigned char* smem) {
    const int tid = otid(), lane = tid & 63, wave = tid >> 6;
    const int gw = blockIdx.x * 8 + wave, NGW = gridDim.x * 8;
    float* sl = (float*)smem;
    float* scr = (float*)(smem + 49152) + wave * (64 * 33);
    if ((int)blockIdx.x * 8 < 384) {
        for (int e = tid; e < 9 * 1024; e += 512) { const int j = e >> 10, k = e & 1023; const float cv = (j == 0) ? p.c_ctx[k] : p.c[(j - 1) * 1024 + k]; sl[k * 12 + j] = cv / (1.f + __expf(-cv)); }
        __syncthreads();
        if (gw < 384) {
            const int cb = gw % 48, kc = gw / 48, col = cb * 64 + lane;
            float a0 = 0, a1 = 0, a2 = 0, a3 = 0, a4 = 0, a5 = 0, a6 = 0, a7 = 0, a8 = 0;
#pragma unroll 16
            for (int k = kc * 128; k < kc * 128 + 128; ++k) {
                const float wv = p.w_ada[(size_t)k * 3072 + col];
                const float4* s4 = (const float4*)(sl + k * 12); const float4 s0 = s4[0], s1 = s4[1], s2 = s4[2];
                a0 += s0.x * wv; a1 += s0.y * wv; a2 += s0.z * wv; a3 += s0.w * wv; a4 += s1.x * wv; a5 += s1.y * wv; a6 += s1.z * wv; a7 += s1.w * wv; a8 += s2.x * wv;
            }
            float* mp = p.modp + (size_t)kc * 9 * 3072 + col;
            mp[0 * 3072] = a0; mp[1 * 3072] = a1; mp[2 * 3072] = a2; mp[3 * 3072] = a3; mp[4 * 3072] = a4; mp[5 * 3072] = a5; mp[6 * 3072] = a6; mp[7 * 3072] = a7; mp[8 * 3072] = a8;
        }
    }
    for (int it = gw; it < 2432 + 512; it += NGW) {
        if (it < 2432) transpose_item(p.w_in, 1024, 4864, p.wt_in, scr, it, lane);
        else transpose_item(p.w_out, 1024, 1024, p.wt_out, scr, it - 2432, lane);
    }
}

__device__ __forceinline__ void phase1(const Params& p, unsigned char* smem) {
    const int tid = otid(), lane = tid & 63, wave = tid >> 6;
    float* gs = (float*)smem; float* sh = gs + 1024;
    if (blockIdx.x < 9) {
        const int row = blockIdx.x;
        for (int c = tid; c < 1024; c += 512) { float s = p.b_ada[2048 + c];
#pragma unroll
            for (int kc = 0; kc < 8; ++kc) s += p.modp[((size_t)kc * 9 + row) * 3072 + 2048 + c];
            p.gate[row * 1024 + c] = s; }
    }
    const int G = gridDim.x, per = (2560 + G - 1) / G; const int g0 = blockIdx.x * per, g1 = (g0 + per) < 2560 ? (g0 + per) : 2560;
    int cur = -1;
    for (int grp = g0; grp < g1; ++grp) {
        const int tok0 = grp * 8; const int row = tok0 < NPTOK ? 0 : 1 + ((tok0 - NPTOK) >> 11);
        if (row != cur) {
            __syncthreads();
            for (int c = tid; c < 1024; c += 512) { float s0 = p.b_ada[c], s1 = p.b_ada[1024 + c];
#pragma unroll
                for (int kc = 0; kc < 8; ++kc) { s0 += p.modp[((size_t)kc * 9 + row) * 3072 + c]; s1 += p.modp[((size_t)kc * 9 + row) * 3072 + 1024 + c]; }
                gs[c] = p.norm_g[c] * (1.f + s1); sh[c] = s0; }
            __syncthreads(); cur = row;
        }
        const bool two = (grp + 1 < g1) && ((tok0 + 8 < NPTOK ? 0 : 1 + ((tok0 + 8 - NPTOK) >> 11)) == row);
        const int tokA = tok0 + wave, tokB = two ? tokA + 8 : tokA;
        const float* xa = tokA < NPTOK ? p.x_prompt + (size_t)tokA * 1024 : p.x_sample + (size_t)(tokA - NPTOK) * 1024;
        const float* xb = tokB < NPTOK ? p.x_prompt + (size_t)tokB * 1024 : p.x_sample + (size_t)(tokB - NPTOK) * 1024;
        float4 va[4], vb[4]; float sa = 0.f, sb = 0.f;
#pragma unroll
        for (int j = 0; j < 4; ++j) { va[j] = ((const float4*)xa)[lane + 64 * j]; vb[j] = ((const float4*)xb)[lane + 64 * j]; }
#pragma unroll
        for (int j = 0; j < 4; ++j) { sa += va[j].x * va[j].x + va[j].y * va[j].y + va[j].z * va[j].z + va[j].w * va[j].w; sb += vb[j].x * vb[j].x + vb[j].y * vb[j].y + vb[j].z * vb[j].z + vb[j].w * vb[j].w; }
        sa = wave_sum_fast(sa); sb = wave_sum_fast(sb);
        const float ra = rsqrtf(sa * (1.f / 1024.f) + 1e-6f), rb = rsqrtf(sb * (1.f / 1024.f) + 1e-6f);
#pragma unroll
        for (int j = 0; j < 4; ++j) { const int c = 4 * (lane + 64 * j); const float4 g4 = *(const float4*)(gs + c), h4 = *(const float4*)(sh + c);
            uint2 o; o.x = cvt_pk_bf16(va[j].x * ra * g4.x + h4.x, va[j].y * ra * g4.y + h4.y); o.y = cvt_pk_bf16(va[j].z * ra * g4.z + h4.z, va[j].w * ra * g4.w + h4.w);
            *(uint2*)(p.xm + (size_t)tokA * 1024 + c) = o;
            if (two) { uint2 o2; o2.x = cvt_pk_bf16(vb[j].x * rb * g4.x + h4.x, vb[j].y * rb * g4.y + h4.y); o2.y = cvt_pk_bf16(vb[j].z * rb * g4.z + h4.z, vb[j].w * rb * g4.w + h4.w);
                *(uint2*)(p.xm + (size_t)tokB * 1024 + c) = o2; } }
        if (two) ++grp;
    }
}

__device__ __forceinline__ void phase3(const Params& p) {
    const int tid = otid(), lane = tid & 63, wave = tid >> 6;
    const int gw = blockIdx.x * 8 + wave, NGW = gridDim.x * 8;
    bf16_t* PS = (bf16_t*)p.out;
    for (int item = gw; item < NTOK * 288 / 64; item += NGW) {
        const int idx = item * 64 + lane, tok = idx / 288, col = (idx - tok * 288) * 8;
        const bool grid = tok >= NPTOK; const int t = grid ? (tok - NPTOK) & 2047 : tok & 255;
        bool hp, hn, vu = false, vd = false;
        if (!grid) { hp = t > 0; hn = t < 255; } else { const int cgx = t & 63, rgy = t >> 6; hp = cgx > 0; hn = cgx < 63; vu = rgy > 0; vd = rgy < 31; }
        const bf16_t* pc = p.pa + (size_t)tok * 2304 + col;
        const u32x4 c0 = *(const u32x4*)pc, c1 = *(const u32x4*)(pc + (hp ? -2304 : 0)), c2 = *(const u32x4*)(pc + (hn ? 2304 : 0));
        const u32x4 c3 = *(const u32x4*)(pc + (vu ? -64 * 2304 : 0)), c4 = *(const u32x4*)(pc + (vd ? 64 * 2304 : 0));
        float mh[8], mv[8]; ld8f(p.mu_h + col, mh); ld8f(p.mu_v + col, mv);
        const float whp = hp ? 0.5f : 0.f, whn = hn ? 0.5f : 0.f, wvu = vu ? 0.5f : 0.f, wvd = vd ? 0.5f : 0.f, gsel = grid ? 1.f : 0.f;
        float x[8], xa[8], xb[8], res[8];
        unpack8(c0, x); unpack8(c1, xa); unpack8(c2, xb);
#pragma unroll
        for (int j = 0; j < 8; ++j) res[j] = x[j] + mh[j] * (whp * xa[j] + whn * xb[j] - x[j]);
        unpack8(c3, xa); unpack8(c4, xb);
#pragma unroll
        for (int j = 0; j < 8; ++j) res[j] += gsel * mv[j] * (wvu * xa[j] + wvd * xb[j] - x[j]);
        const bool is_za = (col >= 1536 && col < 2048), is_wl = (col >= 2048 && ((col - 2048) & 64) == 0);
        if (is_wl) {
#pragma unroll
            for (int j = 0; j < 8; ++j) { const float e2 = __expf(2.f * res[j]); res[j] = 1.f - 2.f * __builtin_amdgcn_rcpf(e2 + 1.f); } }
        if (is_za) {
#pragma unroll
            for (int j = 0; j < 8; ++j) res[j] = res[j] * sigmoidf_(res[j]); }
        u32x4 o; o.x = cvt_pk_bf16(res[0], res[1]); o.y = cvt_pk_bf16(res[2], res[3]); o.z = cvt_pk_bf16(res[4], res[5]); o.w = cvt_pk_bf16(res[6], res[7]);
        bf16_t* dst = is_za ? (p.zs + (size_t)tok * 512 + (col - 1536)) : (PS + (size_t)tok * 1792 + (col < 1536 ? col : col - 512));
        *(u32x4*)dst = o;
    }
}

typedef short s16x4 __attribute__((ext_vector_type(4)));
__device__ __forceinline__ s16x4 pack4(const f32x4 v) { uint2 r; r.x = cvt_pk_bf16(v[0], v[1]); r.y = cvt_pk_bf16(v[2], v[3]); return __builtin_bit_cast(s16x4, r); }
#define MFMA16(a, b, c) __builtin_amdgcn_mfma_f32_16x16x16bf16_1k((a), (b), (c), 0, 0, 0)
__device__ __forceinline__ void rwkv_item(const Params& p, unsigned char* smem, int seq, int d, int h) {
    const int tid = otid(), lane = tid & 63, wave = tid >> 6;
    const bool grid = seq >= 16; const int T = grid ? 2048 : 256; const int g0 = grid ? NPTOK + (seq - 16) * 2048 : seq * 256; const int bidx = grid ? seq - 16 : seq;
    float* RF = (float*)(smem + 0);
    float* KEF = (float*)(smem + 8192);
    float* EF = (float*)(smem + 16384);
    float* KAP = (float*)(smem + 24576);
    float* BF = (float*)(smem + 32768);
    bf16_t* VTb0 = (bf16_t*)(smem + 40960);
    bf16_t* LWb = (bf16_t*)(smem + 51200);
    bf16_t* QH0 = (bf16_t*)(smem + 60416);
    bf16_t* BK = (bf16_t*)(smem + 78848);
    bf16_t* KP0 = (bf16_t*)(smem + 88064);
    bf16_t* AMs0 = (bf16_t*)(smem + 108544);
    float* G150 = (float*)(smem + 122880);
    float* YOUT0 = (float*)(smem + 123904);
    float* BONL = (float*)(smem + 140288);
    bf16_t* WL = (bf16_t*)(smem + 140672);
    const int nmc = T / 32;
    bf16_t* YA = p.pa + (size_t)d * NTOK * 512;
    const bf16_t* PS = (const bf16_t*)p.out;
    float* BON = p.bon + (size_t)d * NTOK * 8;
    const int lr = lane & 15, lq = lane >> 4;

    f32x4 Lacc = {0.f, 0.f, 0.f, 0.f};
    f32x4 ST[4];
#pragma unroll
    for (int kt = 0; kt < 4; ++kt) ST[kt] = (f32x4){0.f, 0.f, 0.f, 0.f};
    if (wave < 4 && grid) { const float* st = p.state_rwkv + ((size_t)(bidx * 2 + d) * 8 + h) * 4096 + (16 * wave + lr) * 64;
#pragma unroll
        for (int kt = 0; kt < 4; ++kt) { const float4 s4 = *(const float4*)(st + 16 * kt + 4 * lq); ST[kt] = (f32x4){s4.x, s4.y, s4.z, s4.w}; } }
    for (int e = tid; e < 2 * 64 * 64; e += 512) { const int ty = e >> 12, k = (e >> 6) & 63, n = e & 63;
        const float wv = ty ? p.a2[(size_t)(d * 64 + k) * 512 + 64 * h + n] : p.w2[(size_t)(d * 64 + k) * 512 + 64 * h + n];
        WL[(ty * 64 + n) * 72 + k] = f2bf(wv); }
    const float ka3 = p.k_a[64 * h + (tid & 63)];
    float kq[8]; ld8f(p.k_k + 64 * h + (tid & 7) * 8, kq);
    float w0c = 0.f, a0c = 0.f, kac = 0.f, rkc = 0.f;
    { const int n = 64 * h + 16 * (wave & 3) + lr; w0c = p.w0[d * 512 + n]; a0c = p.a0[d * 512 + n]; kac = p.k_a[n]; rkc = p.r_k[n]; }

    u32x4 L[3];
#pragma unroll
    for (int m = 0; m < 3; ++m) L[m] = (u32x4){0u, 0u, 0u, 0u};
    auto A_load = [&](int c) {
#pragma unroll
        for (int m = 0; m < 3; ++m) { const int it = tid + 512 * m;
            if (it < 1280) { const int grp = it >> 8, i = (it >> 3) & 31, v8 = it & 7;
                const int col = (grp < 3 ? grp * 512 + 64 * h : 1536 + 128 * d + (grp - 3) * 64) + v8 * 8;
                const int step = c * 32 + i, t = d ? T - 1 - step : step;
                L[m] = *(const u32x4*)(PS + (size_t)(g0 + t) * 1792 + col); } }
    };
    auto prep = [&](int c) {
        const int par = c & 1;
        bf16_t* VTb = VTb0 + par * 2560; bf16_t* QH = QH0 + par * 4608; bf16_t* KP = KP0 + par * 5120; bf16_t* AMs = AMs0 + par * 2560; float* G15 = G150 + par * 128;
        float* BONc = BONL + (c % 3) * 32;
        __builtin_amdgcn_s_waitcnt(0);
        if (tid < 32) BONc[tid] = 0.f;
#pragma unroll
        for (int m = 0; m < 3; ++m) { const int it = tid + 512 * m;
            if (it < 1280) { const int grp = __builtin_amdgcn_readfirstlane(it >> 8), i = (it >> 3) & 31, v8 = it & 7;
                const int cc = v8 * 8; const u32x4 w = L[m];
                if (grp < 2) { float res[8]; unpack8(w, res); float* dst = RF + grp * 2048 + i * 64 + cc;
                    *(float4*)dst = make_float4(res[0], res[1], res[2], res[3]); *(float4*)(dst + 4) = make_float4(res[4], res[5], res[6], res[7]);
                    if (grp == 1) {
                        float ss = 0.f;
#pragma unroll
                        for (int j = 0; j < 8; ++j) { res[j] *= kq[j]; ss += res[j] * res[j]; }
                        ss = red8(ss);
                        const float inv = __builtin_amdgcn_rcpf(fmaxf(__builtin_amdgcn_sqrtf(ss), 1e-12f));
                        *(float4*)(KAP + i * 64 + cc) = make_float4(res[0] * inv, res[1] * inv, res[2] * inv, res[3] * inv); *(float4*)(KAP + i * 64 + cc + 4) = make_float4(res[4] * inv, res[5] * inv, res[6] * inv, res[7] * inv); }
                } else if (grp == 2) {
                    VTb[(cc + 0) * 40 + i] = (bf16_t)(w.x & 0xffffu); VTb[(cc + 1) * 40 + i] = (bf16_t)(w.x >> 16); VTb[(cc + 2) * 40 + i] = (bf16_t)(w.y & 0xffffu); VTb[(cc + 3) * 40 + i] = (bf16_t)(w.y >> 16);
                    VTb[(cc + 4) * 40 + i] = (bf16_t)(w.z & 0xffffu); VTb[(cc + 5) * 40 + i] = (bf16_t)(w.z >> 16); VTb[(cc + 6) * 40 + i] = (bf16_t)(w.w & 0xffffu); VTb[(cc + 7) * 40 + i] = (bf16_t)(w.w >> 16);
                } else {
                    *(u32x4*)(LWb + (grp - 3) * 2304 + i * 72 + cc) = w;
                } } }
        if (c + 1 < nmc) A_load(c + 1);
        __syncthreads();
        { const int wn = wave & 3, u = wave >> 2, n = 16 * wn + lr;
            f32x4 accw = {0.f, 0.f, 0.f, 0.f}, acca = {0.f, 0.f, 0.f, 0.f};
#pragma unroll
            for (int q = 0; q < 2; ++q) {
                const bf16x8 aw = *(const bf16x8*)(LWb + (16 * u + lr) * 72 + q * 32 + lq * 8);
                const bf16x8 aa = *(const bf16x8*)(LWb + 2304 + (16 * u + lr) * 72 + q * 32 + lq * 8);
                const bf16x8 bw = *(const bf16x8*)(WL + (16 * wn + lr) * 72 + q * 32 + lq * 8);
                const bf16x8 ba = *(const bf16x8*)(WL + (64 + 16 * wn + lr) * 72 + q * 32 + lq * 8);
                accw = __builtin_amdgcn_mfma_f32_16x16x32_bf16(aw, bw, accw, 0, 0, 0);
                acca = __builtin_amdgcn_mfma_f32_16x16x32_bf16(aa, ba, acca, 0, 0, 0);
            }
            float ee[4], av[4];
#pragma unroll
            for (int j = 0; j < 4; ++j) { ee[j] = __builtin_amdgcn_rcpf(1.f + __expf(-(w0c + accw[j]))) * 0.60653066f; av[j] = __builtin_amdgcn_rcpf(1.f + __expf(-(a0c + acca[j]))); }
            const float p1 = ee[0] + ee[1], p2 = p1 + ee[2], q4 = p2 + ee[3];
            const float t1 = __shfl_up(q4, 16); const float s1 = q4 + (lq >= 1 ? t1 : 0.f);
            const float t2 = __shfl_up(s1, 32); const float s2 = s1 + (lq >= 2 ? t2 : 0.f);
            const float etot = __shfl(s2, 48 + lr), offp = s2 - q4;
            const float Gtot = __expf(-etot); float Gprev = __expf(-offp), E = offp;
            float kpk[4], kpb[4];
#pragma unroll
            for (int j = 0; j < 4; ++j) { const int tau = 4 * lq + j, i = 16 * u + tau;
                E += ee[j];
                const float Gm1 = Gprev, G = __expf(-E), iG = __builtin_amdgcn_rcpf(G), tail = iG * Gtot; Gprev = G;
                const float kap = KAP[i * 64 + n], r = RF[i * 64 + n], a = av[j]; const float ke = KEF[i * 64 + n] * (1.f + (a - 1.f) * kac), b = kap * a;
                QH[(u * 32 + tau) * 72 + n] = f2bf(kap * Gm1); QH[(u * 32 + 16 + tau) * 72 + n] = f2bf(r * G);
                BK[(u * 32 + tau) * 72 + n] = f2bf(b * iG); BK[(u * 32 + 16 + tau) * 72 + n] = f2bf(ke * iG);
                kpk[j] = ke * tail; kpb[j] = b * tail;
                float pbn = 0.5f * r * ke * rkc; pbn = red16(pbn);
                if (lr == 0) atomicAdd(&BONc[i], pbn); }
            { uint2 o; o.x = cvt_pk_bf16(kpk[0], kpk[1]); o.y = cvt_pk_bf16(kpk[2], kpk[3]); *(uint2*)(KP + ((u * 2 + 0) * 64 + n) * 20 + 4 * lq) = o;
              uint2 o2; o2.x = cvt_pk_bf16(kpb[0], kpb[1]); o2.y = cvt_pk_bf16(kpb[2], kpb[3]); *(uint2*)(KP + ((u * 2 + 1) * 64 + n) * 20 + 4 * lq) = o2; }
            if (lq == 3) G15[u * 64 + n] = Gtot;
        }
        __syncthreads();
    };
    auto S4 = [&](int c) {
        const int par = c & 1; const bf16_t* QH = QH0 + par * 4608; bf16_t* AMs = AMs0 + par * 2560;
        { int u, mi, ni;
          if (wave == 4 || wave == 5) { u = wave - 4; mi = 0; ni = 0; }
          else { const int idx = wave < 4 ? wave : wave - 2; u = idx / 3; const int r3 = idx - 3 * u; mi = (r3 == 0) ? 0 : 1; ni = (r3 == 1) ? 0 : 1; }
          f32x4 acc = {0.f, 0.f, 0.f, 0.f};
#pragma unroll
          for (int q = 0; q < 2; ++q) { const bf16x8 A = *(const bf16x8*)(QH + (u * 32 + 16 * mi + lr) * 72 + q * 32 + lq * 8); const bf16x8 B = *(const bf16x8*)(BK + (u * 32 + 16 * ni + lr) * 72 + q * 32 + lq * 8);
              acc = __builtin_amdgcn_mfma_f32_16x16x32_bf16(A, B, acc, 0, 0, 0); }
          if (wave == 4 || wave == 5) Lacc = acc;
          else {
#pragma unroll
              for (int j = 0; j < 4; ++j) { const int t = lq * 4 + j, sidx = lr;
                  const int mat = (mi == 0) ? 1 : (ni == 1 ? 2 : 3); const bool keep = (mi == 0) ? (sidx < t) : (sidx <= t);
                  AMs[((u * 4 + mat) * 16 + t) * 20 + sidx] = f2bf(keep ? acc[j] : 0.f); } } }
    };
    auto S5 = [&](int c) {
        bf16_t* AMs = AMs0 + (c & 1) * 2560;
        const int u = wave - 4, cI = lr;
        float x[16];
#pragma unroll
        for (int t = 0; t < 16; ++t) x[t] = (t == cI) ? 1.f : 0.f;
#pragma unroll
        for (int sidx = 0; sidx < 15; ++sidx) {
#pragma unroll
            for (int t = sidx + 1; t < 16; ++t) { const float l = __int_as_float(__builtin_amdgcn_readlane(__float_as_int(Lacc[t & 3]), 16 * (t >> 2) + sidx)); x[t] -= l * x[sidx]; } }
        if (lq == 0) {
#pragma unroll
            for (int t = 0; t < 16; ++t) AMs[((u * 4 + 0) * 16 + t) * 20 + cI] = f2bf(-x[t]); }
    };
    auto S6 = [&](int c) {
        const int par = c & 1;
        const bf16_t* VTb = VTb0 + par * 2560; const bf16_t* QH = QH0 + par * 4608; const bf16_t* KP = KP0 + par * 5120; const bf16_t* AMs = AMs0 + par * 2560; const float* G15 = G150 + par * 128;
        float* YOUT = YOUT0 + par * 2048;
#pragma unroll 1
        for (int u = 0; u < 2; ++u) {
            s16x4 STb[4];
#pragma unroll
            for (int kt = 0; kt < 4; ++kt) STb[kt] = pack4(ST[kt]);
            f32x4 W = {0.f, 0.f, 0.f, 0.f}, RS = {0.f, 0.f, 0.f, 0.f};
#pragma unroll
            for (int kt = 0; kt < 4; ++kt) { const s16x4 ak = *(const s16x4*)(QH + (u * 32 + lr) * 72 + 16 * kt + 4 * lq); const s16x4 ar = *(const s16x4*)(QH + (u * 32 + 16 + lr) * 72 + 16 * kt + 4 * lq);
                W = MFMA16(ak, STb[kt], W); RS = MFMA16(ar, STb[kt], RS); }
            const s16x4 Vb = *(const s16x4*)(VTb + (16 * wave + lr) * 40 + 16 * u + 4 * lq);
            const s16x4 aTi = *(const s16x4*)(AMs + ((u * 4 + 0) * 16 + lr) * 20 + 4 * lq), aKk = *(const s16x4*)(AMs + ((u * 4 + 1) * 16 + lr) * 20 + 4 * lq);
            const s16x4 aKr = *(const s16x4*)(AMs + ((u * 4 + 2) * 16 + lr) * 20 + 4 * lq), aBr = *(const s16x4*)(AMs + ((u * 4 + 3) * 16 + lr) * 20 + 4 * lq);
            const f32x4 Z = MFMA16(aKk, Vb, W);
            const s16x4 Zb = pack4(Z);
            const f32x4 zero = {0.f, 0.f, 0.f, 0.f};
            const f32x4 U = MFMA16(aTi, Zb, zero);
            const s16x4 Ub = pack4(U);
            f32x4 Y = MFMA16(aKr, Vb, RS); Y = MFMA16(aBr, Ub, Y);
#pragma unroll
            for (int j = 0; j < 4; ++j) YOUT[(16 * u + 4 * lq + j) * 64 + 16 * wave + lr] = Y[j];
#pragma unroll
            for (int kt = 0; kt < 4; ++kt) { const float4 g4 = *(const float4*)(G15 + u * 64 + 16 * kt + 4 * lq);
                f32x4 sv = ST[kt]; sv[0] *= g4.x; sv[1] *= g4.y; sv[2] *= g4.z; sv[3] *= g4.w;
                const s16x4 akp = *(const s16x4*)(KP + ((u * 2 + 0) * 64 + 16 * kt + lr) * 20 + 4 * lq), abp = *(const s16x4*)(KP + ((u * 2 + 1) * 64 + 16 * kt + lr) * 20 + 4 * lq);
                sv = MFMA16(akp, Vb, sv); sv = MFMA16(abp, Ub, sv); ST[kt] = sv; }
        }
    };
    auto writeout = [&](int c) {
        const float* YOUT = YOUT0 + (c & 1) * 2048; const float* BONc = BONL + (c % 3) * 32;
        const int tid3 = tid - 384;
        for (int e = tid3; e < 512; e += 128) { const int i = e >> 4, c4 = (e & 15) * 4;
            const int step = c * 32 + i, t = d ? T - 1 - step : step;
            const float4 y4 = *(const float4*)(YOUT + i * 64 + c4);
            uint2 o; o.x = cvt_pk_bf16(y4.x, y4.y); o.y = cvt_pk_bf16(y4.z, y4.w);
            *(uint2*)(YA + (size_t)(g0 + t) * 512 + 64 * h + c4) = o; }
        if (tid3 < 32) { const int st2 = c * 32 + tid3, t2 = d ? T - 1 - st2 : st2; BON[(size_t)(g0 + t2) * 8 + h] = BONc[tid3]; }
    };

    __syncthreads();
    A_load(0);
    prep(0);
    S4(0);
    if (wave == 4 || wave == 5) S5(0);
    __syncthreads();
    for (int c = 0; c < nmc; ++c) {
        const bool more = (c + 1) < nmc;
        if (more) { prep(c + 1); S4(c + 1); }
        if (wave < 4) S6(c);
        else if (wave < 6) { if (more) S5(c + 1); }
        else if (c > 0) writeout(c - 1);
        __syncthreads();
    }
    if (wave >= 6) writeout(nmc - 1);
    if (wave < 4 && !grid) { float* st = p.out + OUT_SA + ((size_t)(bidx * 2 + d) * 8 + h) * 4096 + (16 * wave + lr) * 64;
#pragma unroll
        for (int kt = 0; kt < 4; ++kt) *(float4*)(st + 16 * kt + 4 * lq) = make_float4(ST[kt][0], ST[kt][1], ST[kt][2], ST[kt][3]); }
    __syncthreads();
}

__device__ __forceinline__ void hgrn_item(const Params& p, unsigned char* smem, int seq, int d, int h, int vh) {
    const int tid = otid(), lane = tid & 63, wave = tid >> 6;
    const bool grid = seq >= 16; const int T = grid ? 2048 : 256; const int g0 = grid ? NPTOK + (seq - 16) * 2048 : seq * 256; const int bidx = grid ? seq - 16 : seq;
    bf16_t* QT = (bf16_t*)(smem + 0);
    bf16_t* KT = (bf16_t*)(smem + 17408);
    bf16_t* ST = (bf16_t*)(smem + 34816);
    bf16_t* KH = (bf16_t*)(smem + 52224);
    bf16_t* AM = (bf16_t*)(smem + 70656);
    bf16_t* VT = (bf16_t*)(smem + 79872);
    float* GC = (float*)(smem + 89088);
    float* GSUM = (float*)(smem + 89600);
    const int nch = T / 64;
    const int lr = lane & 15, lq = lane >> 4;
    bf16_t* OB = p.pa + (size_t)NTOK * 1024 + (size_t)d * NTOK * 512;
#ifdef SKIP_HGRN
    for (int e = tid; e < T * 64; e += 512) OB[(size_t)(g0 + (e >> 6)) * 512 + 128 * h + 64 * vh + (e & 63)] = 0;
    if (!grid) for (int e = tid; e < 8192; e += 512) p.out[OUT_SB + ((size_t)((bidx * 2 + d) * 4 + h) * 128 + (e >> 6)) * 128 + 64 * vh + (e & 63)] = 0.f;
    return;
#endif

    f32x4 sacc[4];
#pragma unroll
    for (int x = 0; x < 4; ++x) { const int id = 4 * wave + x, tv = id >> 3, tk = id & 7;
#pragma unroll
        for (int j = 0; j < 4; ++j) { const int v = tv * 16 + lq * 4 + j, k = tk * 16 + lr;
            const float s = grid ? p.state_hgrn[((size_t)((bidx * 2 + d) * 4 + h) * 128 + k) * 128 + 64 * vh + v] : 0.f;
            sacc[x][j] = s; ST[v * 136 + k] = f2bf(s); } }
    const int kch = 16 * wave + (lane & 15), qd = lane >> 4;

    bf16_t rf[16], rq[16]; u32x4 rv = {0u, 0u, 0u, 0u};
    auto load_raw = [&](int c) {
#pragma unroll
        for (int ii = 0; ii < 16; ++ii) { const int step = c * 64 + 16 * qd + ii, t = d ? T - 1 - step : step; const bf16_t* row = p.pb + (size_t)(g0 + t) * 2560;
            rf[ii] = row[1024 + 512 * d + 128 * h + kch]; rq[ii] = row[128 * h + kch]; }
        { const int s = tid >> 3, v8 = (tid & 7) * 8; const int step = c * 64 + s, t = d ? T - 1 - step : step;
          rv = *(const u32x4*)(p.pb + (size_t)(g0 + t) * 2560 + 512 + 128 * h + 64 * vh + v8); }
    };
    load_raw(0);
    for (int c = 0; c < nch; ++c) {
        float G[16], qv[16], kv[16]; float run = 0.f;
#pragma unroll
        for (int ii = 0; ii < 16; ++ii) {
            const float g = bf2f(rf[ii]);
            run += g; G[ii] = run; qv[ii] = bf2f(rq[ii]); kv[ii] = 1.f - __expf(g); }
        { const int s = tid >> 3, v8 = (tid & 7) * 8; const u32x4 w = rv;
          VT[(v8 + 0) * 72 + s] = (bf16_t)(w.x & 0xffffu); VT[(v8 + 1) * 72 + s] = (bf16_t)(w.x >> 16); VT[(v8 + 2) * 72 + s] = (bf16_t)(w.y & 0xffffu); VT[(v8 + 3) * 72 + s] = (bf16_t)(w.y >> 16);
          VT[(v8 + 4) * 72 + s] = (bf16_t)(w.z & 0xffffu); VT[(v8 + 5) * 72 + s] = (bf16_t)(w.z >> 16); VT[(v8 + 6) * 72 + s] = (bf16_t)(w.w & 0xffffu); VT[(v8 + 7) * 72 + s] = (bf16_t)(w.w >> 16); }
        if (c + 1 < nch) load_raw(c + 1);
        const float t1 = __shfl_up(run, 16); const float s1 = run + (qd >= 1 ? t1 : 0.f);
        const float t2 = __shfl_up(s1, 32); const float s2 = s1 + (qd >= 2 ? t2 : 0.f);
        const float off = s2 - run, tot = __shfl(s2, 48 + (lane & 15));
        const float etot = __expf(tot);
        float khv[16];
#pragma unroll
        for (int ii = 0; ii < 16; ++ii) { const int i = 16 * qd + ii; const float Gi = G[ii] + off;
            const float eg = __expf(Gi), ieg = __builtin_amdgcn_rcpf(eg), kie = kv[ii] * ieg;
            QT[i * 136 + kch] = f2bf(qv[ii] * eg); KT[i * 136 + kch] = f2bf(kie); khv[ii] = kie * etot; }
        { u32x4 o0, o1;
          o0.x = cvt_pk_bf16(khv[0], khv[1]); o0.y = cvt_pk_bf16(khv[2], khv[3]); o0.z = cvt_pk_bf16(khv[4], khv[5]); o0.w = cvt_pk_bf16(khv[6], khv[7]);
          o1.x = cvt_pk_bf16(khv[8], khv[9]); o1.y = cvt_pk_bf16(khv[10], khv[11]); o1.z = cvt_pk_bf16(khv[12], khv[13]); o1.w = cvt_pk_bf16(khv[14], khv[15]);
          *(u32x4*)(KH + kch * 72 + 16 * qd) = o0; *(u32x4*)(KH + kch * 72 + 16 * qd + 8) = o1; }
        if (qd == 0) GC[kch] = etot;
        __syncthreads();
        f32x4 oacc[2];
#pragma unroll
        for (int x = 0; x < 2; ++x) { const int id = 2 * wave + x, tm = id >> 2, tn = id & 3;
            f32x4 a = {0.f, 0.f, 0.f, 0.f}, o = {0.f, 0.f, 0.f, 0.f};
#pragma unroll
            for (int q = 0; q < 4; ++q) { const bf16x8 A = *(const bf16x8*)(QT + (tm * 16 + lr) * 136 + q * 32 + lq * 8);
                const bf16x8 Bk = *(const bf16x8*)(KT + (tn * 16 + lr) * 136 + q * 32 + lq * 8); const bf16x8 Bs = *(const bf16x8*)(ST + (tn * 16 + lr) * 136 + q * 32 + lq * 8);
                a = __builtin_amdgcn_mfma_f32_16x16x32_bf16(A, Bk, a, 0, 0, 0); o = __builtin_amdgcn_mfma_f32_16x16x32_bf16(A, Bs, o, 0, 0, 0); }
#pragma unroll
            for (int j = 0; j < 4; ++j) { const int trow = tm * 16 + lq * 4 + j, scol = tn * 16 + lr; AM[trow * 72 + scol] = f2bf(scol <= trow ? a[j] : 0.f); }
            oacc[x] = o; }
        __syncthreads();
#pragma unroll
        for (int x = 0; x < 2; ++x) { const int id = 2 * wave + x, tm = id >> 2, tn = id & 3;
#pragma unroll
            for (int q = 0; q < 2; ++q) { const bf16x8 A = *(const bf16x8*)(AM + (tm * 16 + lr) * 72 + q * 32 + lq * 8); const bf16x8 B = *(const bf16x8*)(VT + (tn * 16 + lr) * 72 + q * 32 + lq * 8);
                oacc[x] = __builtin_amdgcn_mfma_f32_16x16x32_bf16(A, B, oacc[x], 0, 0, 0); }
#pragma unroll
            for (int j = 0; j < 4; ++j) { const int i = tm * 16 + lq * 4 + j; const int step = c * 64 + i, t = d ? T - 1 - step : step;
                OB[(size_t)(g0 + t) * 512 + 128 * h + 64 * vh + tn * 16 + lr] = f2bf(oacc[x][j]); } }
#pragma unroll
        for (int x = 0; x < 4; ++x) { const int id = 4 * wave + x, tv = id >> 3, tk = id & 7; const float gc = GC[tk * 16 + lr];
            sacc[x] = sacc[x] * gc;
#pragma unroll
            for (int q = 0; q < 2; ++q) { const bf16x8 A = *(const bf16x8*)(VT + (tv * 16 + lr) * 72 + q * 32 + lq * 8); const bf16x8 B = *(const bf16x8*)(KH + (tk * 16 + lr) * 72 + q * 32 + lq * 8);
                sacc[x] = __builtin_amdgcn_mfma_f32_16x16x32_bf16(A, B, sacc[x], 0, 0, 0); }
#pragma unroll
            for (int j = 0; j < 4; ++j) ST[(tv * 16 + lq * 4 + j) * 136 + tk * 16 + lr] = f2bf(sacc[x][j]); }
        __syncthreads();
    }
    if (!grid) {
#pragma unroll
        for (int x = 0; x < 4; ++x) { const int id = 4 * wave + x, tv = id >> 3, tk = id & 7;
#pragma unroll
            for (int j = 0; j < 4; ++j) { const int v = tv * 16 + lq * 4 + j, k = tk * 16 + lr;
                p.out[OUT_SB + ((size_t)((bidx * 2 + d) * 4 + h) * 128 + k) * 128 + 64 * vh + v] = sacc[x][j]; } }
    }
    __syncthreads();
}

__device__ __forceinline__ void phase4(const Params& p, unsigned char* smem, int mode = 0) {
    const int G = gridDim.x, b = blockIdx.x;
    const bool fast = (G == 256);
    const int n_it = fast ? (b < 128 ? 1 : 5) : (768 - b + G - 1) / G;
    for (int n = 0; n < n_it; ++n) {
        const int it = fast ? (n == 0 ? b : 256 + (b - 128) + 128 * (n - 1)) : (b + n * G);
        if ((mode == 1 && it >= 128) || (mode == 2 && it < 128) || (mode == 3 && !(it >= 128 && it < 256))) continue;
        if (it < 128) rwkv_item(p, smem, 16 + (it >> 4), (it >> 3) & 1, it & 7);
        else if (it < 256) { const int j = it - 128; hgrn_item(p, smem, 16 + (j >> 4), (j >> 3) & 1, (j >> 1) & 3, j & 1); }
        else if (it < 512) { const int q = it - 256; rwkv_item(p, smem, q >> 4, (q >> 3) & 1, q & 7); }
        else { const int q2 = it - 512; hgrn_item(p, smem, q2 >> 4, (q2 >> 3) & 1, (q2 >> 1) & 3, q2 & 1); }
    }
}

__device__ __forceinline__ void phase5(const Params& p) {
    const int tid = otid(), lane = tid & 63, wave = tid >> 6;
    const int gw = blockIdx.x * 8 + wave, NGW = gridDim.x * 8;
    const bf16_t* YA0 = p.pa; const bf16_t* YA1 = YA0 + (size_t)NTOK * 512;
    const bf16_t* OB0 = YA0 + (size_t)NTOK * 1024; const bf16_t* OB1 = OB0 + (size_t)NTOK * 512;
    bf16_t* mix = p.xm;
    const int c8 = 8 * lane;
    float lw[8], lb8[8], og[8];
    ld8f(p.lnx_w + c8, lw); ld8f(p.lnx_b + c8, lb8); ld8f(p.onorm_g + c8, og);
    for (int tok = gw; tok < NTOK; tok += NGW) {
        const u32x4 ya0 = *(const u32x4*)(YA0 + (size_t)tok * 512 + c8), ya1 = *(const u32x4*)(YA1 + (size_t)tok * 512 + c8);
        const u32x4 ob0 = *(const u32x4*)(OB0 + (size_t)tok * 512 + c8), ob1 = *(const u32x4*)(OB1 + (size_t)tok * 512 + c8);
        const u32x4 v_c = *(const u32x4*)((const bf16_t*)p.out + (size_t)tok * 1792 + 1024 + c8), z_c = *(const u32x4*)(p.zs + (size_t)tok * 512 + c8);
        const u32x4 zb4 = *(const u32x4*)(p.pb + (size_t)tok * 2560 + 2048 + c8);
        const int hA = lane >> 3;
        const float bonus = p.bon[(size_t)tok * 8 + hA] + p.bon[(size_t)NTOK * 8 + (size_t)tok * 8 + hA];
        float y[8], tmp[8], vv[8], zz[8];
        unpack8(ya0, y); unpack8(ya1, tmp);
        float s = 0.f;
#pragma unroll
        for (int j = 0; j < 8; ++j) { y[j] += tmp[j]; s += y[j]; }
        const float mean = red8(s) * (1.f / 64.f);
        float q = 0.f;
#pragma unroll
        for (int j = 0; j < 8; ++j) { y[j] -= mean; q += y[j] * y[j]; }
        const float rstd = rsqrtf(red8(q) * (1.f / 64.f) + 64e-5f);
        unpack8(v_c, vv); unpack8(z_c, zz);
        float o[8];
#pragma unroll
        for (int j = 0; j < 8; ++j) o[j] = (y[j] * rstd * lw[j] + lb8[j] + bonus * vv[j]) * zz[j];
        { u32x4 w; w.x = cvt_pk_bf16(o[0], o[1]); w.y = cvt_pk_bf16(o[2], o[3]); w.z = cvt_pk_bf16(o[4], o[5]); w.w = cvt_pk_bf16(o[6], o[7]); *(u32x4*)(mix + (size_t)tok * 1024 + c8) = w; }
        unpack8(ob0, y); unpack8(ob1, tmp); unpack8(zb4, zz);
        float ss = 0.f;
#pragma unroll
        for (int j = 0; j < 8; ++j) { y[j] += tmp[j]; ss += y[j] * y[j]; }
        const float rs = rsqrtf(red16(ss) * (1.f / 128.f) + 1e-6f);
#pragma unroll
        for (int j = 0; j < 8; ++j) o[j] = y[j] * rs * og[j] * (zz[j] * sigmoidf_(zz[j]));
        { u32x4 w; w.x = cvt_pk_bf16(o[0], o[1]); w.y = cvt_pk_bf16(o[2], o[3]); w.z = cvt_pk_bf16(o[4], o[5]); w.w = cvt_pk_bf16(o[6], o[7]); *(u32x4*)(mix + (size_t)tok * 1024 + 512 + c8) = w; }
    }
}

__device__ __forceinline__ void phase7(const Params& p) {
    const int tid = otid(), lane = tid & 63, wave = tid >> 6;
    const int gw = blockIdx.x * 8 + wave, NGW = gridDim.x * 8;
    const bool split = (gridDim.x == 256);
    float ga[8], gb[8]; ld8f(p.final_g + 8 * lane, ga); ld8f(p.final_g + 512 + 8 * lane, gb);
    for (int tok = gw; tok < NTOK; tok += 2 * NGW) {
        const bool two = (tok + NGW) < NTOK; const int tokb = two ? tok + NGW : tok;
        const bf16_t* ha = p.pb + (size_t)tok * 1024; const bf16_t* hb = p.pb + (size_t)tokb * 1024;
        const u32x4 a0 = *(const u32x4*)(ha + 8 * lane), a1 = *(const u32x4*)(ha + 512 + 8 * lane), b0 = *(const u32x4*)(hb + 8 * lane), b1 = *(const u32x4*)(hb + 512 + 8 * lane);
        float xa0[8], xa1[8], xb0[8], xb1[8]; unpack8(a0, xa0); unpack8(a1, xa1); unpack8(b0, xb0); unpack8(b1, xb1);
        if (split) {
            if (tok >= 16384) { const bf16_t* q = p.pa + (size_t)(tok - 16384) * 1024; float t0[8], t1[8]; unpack8(*(const u32x4*)(q + 8 * lane), t0); unpack8(*(const u32x4*)(q + 512 + 8 * lane), t1);
#pragma unroll
                for (int j = 0; j < 8; ++j) { xa0[j] += t0[j]; xa1[j] += t1[j]; } }
            if (tokb >= 16384) { const bf16_t* q = p.pa + (size_t)(tokb - 16384) * 1024; float t0[8], t1[8]; unpack8(*(const u32x4*)(q + 8 * lane), t0); unpack8(*(const u32x4*)(q + 512 + 8 * lane), t1);
#pragma unroll
                for (int j = 0; j < 8; ++j) { xb0[j] += t0[j]; xb1[j] += t1[j]; } }
        }
        float sa = 0.f, sb = 0.f;
#pragma unroll
        for (int j = 0; j < 8; ++j) { sa += xa0[j] * xa0[j] + xa1[j] * xa1[j]; sb += xb0[j] * xb0[j] + xb1[j] * xb1[j]; }
        sa = wave_sum_fast(sa); sb = wave_sum_fast(sb);
        const float ra = rsqrtf(sa * (1.f / 1024.f) + 1e-6f), rb = rsqrtf(sb * (1.f / 1024.f) + 1e-6f);
        float* ya = p.out + (size_t)tok * 1024; float* yb = p.out + (size_t)tokb * 1024;
        *(float4*)(ya + 8 * lane) = make_float4(xa0[0] * ra * ga[0], xa0[1] * ra * ga[1], xa0[2] * ra * ga[2], xa0[3] * ra * ga[3]);
        *(float4*)(ya + 8 * lane + 4) = make_float4(xa0[4] * ra * ga[4], xa0[5] * ra * ga[5], xa0[6] * ra * ga[6], xa0[7] * ra * ga[7]);
        *(float4*)(ya + 512 + 8 * lane) = make_float4(xa1[0] * ra * gb[0], xa1[1] * ra * gb[1], xa1[2] * ra * gb[2], xa1[3] * ra * gb[3]);
        *(float4*)(ya + 512 + 8 * lane + 4) = make_float4(xa1[4] * ra * gb[4], xa1[5] * ra * gb[5], xa1[6] * ra * gb[6], xa1[7] * ra * gb[7]);
        if (two) {
            *(float4*)(yb + 8 * lane) = make_float4(xb0[0] * rb * ga[0], xb0[1] * rb * ga[1], xb0[2] * rb * ga[2], xb0[3] * rb * ga[3]);
            *(float4*)(yb + 8 * lane + 4) = make_float4(xb0[4] * rb * ga[4], xb0[5] * rb * ga[5], xb0[6] * rb * ga[6], xb0[7] * rb * ga[7]);
            *(float4*)(yb + 512 + 8 * lane) = make_float4(xb1[0] * rb * gb[0], xb1[1] * rb * gb[1], xb1[2] * rb * gb[2], xb1[3] * rb * gb[3]);
            *(float4*)(yb + 512 + 8 * lane + 4) = make_float4(xb1[4] * rb * gb[4], xb1[5] * rb * gb[5], xb1[6] * rb * gb[6], xb1[7] * rb * gb[7]);
        }
    }
}

#define XB_TMO      128
#define XB_XCNT(j)  (256  + 64 * (j))
#define XB_XSUB(j)  (1280 + 64 * (j))
#define XB_XGEN(j)  (2304 + 64 * (j))
#define XB_TOP      3328
#define XB_TOPGEN   3392
#define XCD_BAR_WORDS 3456
#define XB_SPIN_CAP (1u << 18)
#define XLAS __attribute__((address_space(3)))

__device__ __forceinline__ unsigned xb_ld(unsigned* p)              { return __hip_atomic_load(p, __ATOMIC_RELAXED, __HIP_MEMORY_SCOPE_AGENT); }
__device__ __forceinline__ unsigned xb_add(unsigned* p, unsigned v) { return __hip_atomic_fetch_add(p, v, __ATOMIC_RELAXED, __HIP_MEMORY_SCOPE_AGENT); }
__device__ __forceinline__ unsigned xb_xcc_id() { return (unsigned)__builtin_amdgcn_s_getreg((3 << 11) | 20) & 0xFu; }
#define XB_SPIN(cond, bar) do { unsigned _sp = 0; while (cond) { __builtin_amdgcn_s_sleep(1); \
    if ((++_sp & 255u) == 0u) { if (xb_ld(&(bar)[XB_TMO])) break; if (_sp > XB_SPIN_CAP) { atomicAdd(&(bar)[XB_TMO], 1u); break; } } } } while (0)

struct XcdBarrier {
    unsigned* bar; unsigned x;
    volatile XLAS unsigned* st;
};

__device__ __forceinline__ XcdBarrier xcd_barrier_post(unsigned* bar, volatile XLAS unsigned* st) {
    XcdBarrier b; b.bar = bar; b.x = xb_xcc_id(); b.st = st;
    if (threadIdx.x == 0) (void)xb_add(&bar[XB_XCNT(b.x)], 1u);
    return b;
}
__device__ __forceinline__ void xcd_barrier_complete(unsigned* bar, unsigned x, unsigned& nloc, unsigned& nx) {
    const unsigned G = gridDim.x * gridDim.y * gridDim.z;
    unsigned sum, cnt, mine, sp = 0u;
    for (;;) {
        sum = 0u; cnt = 0u; mine = 0u;
#pragma unroll
        for (unsigned j = 0; j < 16; ++j) { const unsigned c = xb_ld(&bar[XB_XCNT(j)]); sum += c; cnt += (c > 0u) ? 1u : 0u; mine = (j == x) ? c : mine; }
        if (sum == G) break;
        __builtin_amdgcn_s_sleep(1);
        if ((++sp & 255u) == 0u) { if (xb_ld(&bar[XB_TMO])) break; if (sp > XB_SPIN_CAP) { atomicAdd(&bar[XB_TMO], 1u); break; } }
    }
    nloc = mine > 0u ? mine : 1u; nx = cnt > 0u ? cnt : 1u;
}

__device__ __forceinline__ void xcd_barrier(const XcdBarrier& b) {
    asm volatile("s_waitcnt vmcnt(0)" ::: "memory");
    __syncthreads();
    if (threadIdx.x == 0) {
        unsigned* bar = b.bar;
        __builtin_amdgcn_s_waitcnt(0);
        unsigned nloc = b.st[0], nx = b.st[1];
        if (nloc == 0u) { xcd_barrier_complete(bar, b.x, nloc, nx); b.st[0] = nloc; b.st[1] = nx; }
        const unsigned old = xb_add(&bar[XB_XSUB(b.x)], 1u);
        const unsigned gen = old / nloc;
        if (old + 1u == (gen + 1u) * nloc) {
            __builtin_amdgcn_fence(__ATOMIC_RELEASE, "agent");
            asm volatile("s_waitcnt vmcnt(0)" ::: "memory");
            const unsigned og = xb_add(&bar[XB_TOP], 1u);
            const unsigned tg = og / nx;
            if (og + 1u == (tg + 1u) * nx) xb_add(&bar[XB_TOPGEN], 1u);
            else XB_SPIN(xb_ld(&bar[XB_TOPGEN]) == tg, bar);
            __builtin_amdgcn_fence(__ATOMIC_ACQUIRE, "agent");
            xb_add(&bar[XB_XGEN(b.x)], 1u);
            asm volatile("s_waitcnt vmcnt(0)" ::: "memory");
        } else {
            XB_SPIN(xb_ld(&bar[XB_XGEN(b.x)]) == gen, bar);
            __builtin_amdgcn_fence(__ATOMIC_ACQUIRE, "agent");
            asm volatile("s_waitcnt vmcnt(0)" ::: "memory");
        }
    }
    __syncthreads();
}


__device__ __forceinline__ void gsync(cg::grid_group& g) {
    asm volatile("s_waitcnt vmcnt(0) lgkmcnt(0)" ::: "memory");
    g.sync();
    if (threadIdx.x < 64) { __builtin_amdgcn_fence(__ATOMIC_ACQUIRE, "agent"); asm volatile("s_waitcnt vmcnt(0)" ::: "memory"); }
    __syncthreads();
}
__global__ __launch_bounds__(512, 2) void fwd_megakernel(Params p) {
    extern __shared__ __attribute__((aligned(16))) unsigned char shm[];
    cg::grid_group grid = cg::this_grid();
    volatile XLAS unsigned* xst = (volatile XLAS unsigned*)(shm + LDS_BYTES - 16);
    if (threadIdx.x == 0) { xst[0] = 0u; xst[1] = 0u; }
    __syncthreads();
    const XcdBarrier xb = xcd_barrier_post(p.bar, xst);
    bool dup_done = false; (void)dup_done;
    for (int ph = p.ph_lo; ph < p.ph_hi; ++ph) {
        if (ph == 0) phase0(p, shm);
        else if (ph == 1) phase1(p, shm);
        else if (ph == 2) { pg8::StaticOrder S; S.init(NTOK, 4864, (int)gridDim.x, (int)blockIdx.x); pg8::Gemm g{p.xm, p.wt_in, NTOK, 4864, 1024, 1024}; pg8::EpiP E{p.pa, p.pb, p.lb_logits};
            pg8::gemm_phase<pg8::EpiP, pg8::StaticOrder>((PG8_LAS unsigned char*)shm, g, S, E); }
        else if (ph == 3) phase3(p);
#ifdef P4MODE
        else if (ph == 4) phase4(p, shm, dup_done ? P4MODE : 0);
#else
        else if (ph == 4) phase4(p, shm);
#endif
        else if (ph == 5) phase5(p);
        else if (ph == 6) {
            if (gridDim.x == 256) {
                const int b = blockIdx.x;
                { pg8::OrderOne S{8 * (b & 7) + (b >> 5), (b >> 3) & 3, true}; pg8::Gemm g{p.xm, p.wt_out, NTOK, 1024, 1024, 1024}; pg8::EpiH E{p.x_prompt, p.x_sample, p.gate, p.pb, p.pa, 0};
                  pg8::gemm_phase<pg8::EpiH, pg8::OrderOne>((PG8_LAS unsigned char*)shm, g, S, E); }
                { const int u2 = b >> 1, half = b & 1; pg8::OrderOne S{64 + (u2 >> 2), u2 & 3, b < 128};
                  pg8::Gemm g{p.xm + 512 * half, p.wt_out + 512 * half, NTOK, 1024, 512, 1024}; pg8::EpiH E{p.x_prompt, p.x_sample, p.gate, p.pb, p.pa, half};
                  pg8::gemm_phase<pg8::EpiH, pg8::OrderOne>((PG8_LAS unsigned char*)shm, g, S, E); }
            } else { pg8::StaticOrder S; S.init(NTOK, 1024, (int)gridDim.x, (int)blockIdx.x); pg8::Gemm g{p.xm, p.wt_out, NTOK, 1024, 1024, 1024}; pg8::EpiH E{p.x_prompt, p.x_sample, p.gate, p.pb, p.pa, 0};
                pg8::gemm_phase<pg8::EpiH, pg8::StaticOrder>((PG8_LAS unsigned char*)shm, g, S, E); }
        }
        else phase7(p);
        if (ph + 1 < p.ph_hi) { if (p.ph_lo < 0) gsync(grid); else xcd_barrier(xb); }
#ifdef DUPPH
        if (ph == DUPPH && !dup_done) { dup_done = true; --ph; }
#endif
    }
}

#ifndef NLAUNCH
#define NLAUNCH 1
#endif
extern "C" void kernel_launch(void* const* d_in, const int* in_sizes, int n_in, void* d_out, int out_size, void* d_ws, size_t ws_size, hipStream_t stream) {
    static int grid_blocks = 0;
    if (grid_blocks == 0) {
        if (n_in != 25 || ws_size < WS_END) { fprintf(stderr, "kernel_launch: unexpected n_in %d / ws %zu (need %zu)\n", n_in, ws_size, (size_t)WS_END); grid_blocks = -1; return; }
        int dev = 0, cus = 0, per_cu = 0;
        hipGetDevice(&dev);
        hipDeviceGetAttribute(&cus, hipDeviceAttributeMultiprocessorCount, dev);
        hipFuncSetAttribute((const void*)fwd_megakernel, hipFuncAttributeMaxDynamicSharedMemorySize, LDS_BYTES);
        hipOccupancyMaxActiveBlocksPerMultiprocessor(&per_cu, (const void*)fwd_megakernel, 512, LDS_BYTES);
        if (per_cu < 1) { fprintf(stderr, "kernel_launch: occupancy query says %d blocks per CU\n", per_cu); grid_blocks = -1; return; }
        grid_blocks = cus;
    }
    if (grid_blocks < 0) return;
    Params p{};
    const float* const* in = (const float* const*)d_in;
    p.x_prompt = in[0]; p.x_sample = in[1]; p.state_rwkv = in[2]; p.state_hgrn = in[3]; p.c = in[4]; p.c_ctx = in[5]; p.norm_g = in[6]; p.w_ada = in[7]; p.b_ada = in[8]; p.w_in = in[9];
    p.mu_h = in[10]; p.mu_v = in[11]; p.w0 = in[12]; p.w2 = in[13]; p.a0 = in[14]; p.a2 = in[15]; p.k_k = in[16]; p.k_a = in[17]; p.r_k = in[18]; p.lnx_w = in[19]; p.lnx_b = in[20];
    p.lb_logits = in[21]; p.onorm_g = in[22]; p.w_out = in[23]; p.final_g = in[24];
    p.out = (float*)d_out;
    unsigned char* ws = (unsigned char*)d_ws;
    p.modp = (float*)(ws + WS_MODP); p.gate = (float*)(ws + WS_GATE); p.bon = (float*)(ws + WS_BON); p.wt_in = (bf16_t*)(ws + WS_WTIN); p.wt_out = (bf16_t*)(ws + WS_WTOUT);
    p.xm = (bf16_t*)(ws + WS_XM); p.pa = (bf16_t*)(ws + WS_PA); p.pb = (bf16_t*)(ws + WS_PB); p.zs = (bf16_t*)(ws + WS_WTIN);
    p.bar = (unsigned*)(ws + WS_BAR);
    hipMemsetAsync(ws + WS_BAR, 0, XCD_BAR_WORDS * sizeof(unsigned), stream);
#if NLAUNCH == 1
    p.ph_lo = 0; p.ph_hi = 8;
    void* args[] = {&p};
    hipError_t e = hipLaunchCooperativeKernel((const void*)fwd_megakernel, dim3(grid_blocks), dim3(512), args, LDS_BYTES, stream);
    if (e != hipSuccess) fprintf(stderr, "cooperative launch failed: %s (grid %d)\n", hipGetErrorString(e), grid_blocks);
#else
    for (int ph = 0; ph < 8; ++ph) { p.ph_lo = ph; p.ph_hi = ph + 1; hipLaunchKernelGGL(fwd_megakernel, dim3(grid_blocks), dim3(512), LDS_BYTES, stream, p); }
#endif
}
```

```cpp
#include <hip/hip_runtime.h>
#include <hip/hip_cooperative_groups.h>
#include <cstdio>
#include <cstdint>
namespace cg = cooperative_groups;

namespace pg8 {
#define PG8_LAS __attribute__((address_space(3)))
typedef unsigned short bf16_t;
typedef short bf16x8 __attribute__((ext_vector_type(8)));
typedef float f32x4 __attribute__((ext_vector_type(4)));
typedef unsigned u32x4 __attribute__((ext_vector_type(4)));
constexpr int BM = 256, BK = 64, HALF = 128, HTB = HALF * BK * 2, STAGE_BYTES = 8 * HTB, NXCD = 8, WGM = 8;

__host__ __device__ __forceinline__ int lds_byte(int r, int c) { const int st = (r >> 4) * 2 + (c >> 5), rr = r & 15, cc = c & 31, ob = rr * 64 + cc * 2; return st * 1024 + (ob ^ (((ob >> 9) & 1) << 5)); }
__host__ __device__ __forceinline__ void stage_rc(int b, int& R, int& C) { const int st = b / 1024, sb = b % 1024, swz = sb ^ (((sb >> 9) & 1) << 5); R = (st >> 1) * 16 + swz / 64; C = (st & 1) * 32 + (swz % 64) / 2; }
__host__ __device__ __forceinline__ int perm32(int rho) { const int n = rho >> 4, i = rho & 15; return 8 * (i >> 2) + 4 * n + (i & 3); }

struct Unit { int pm, pn; };
struct Gemm { const bf16_t* A; const bf16_t* Bt; int M, N, K, ld; };

struct StaticOrder {
    int nM, nN, nwg, G, c;
    __host__ __device__ void init(int M, int N, int G_, int c_) { nM = M / BM; nN = N / BM; nwg = nM * nN; G = G_; c = c_; }
    __host__ __device__ bool next(int i, Unit& u) const {
        const long L = (long)i * G + c; if (L >= nwg) return false;
        int wgid = (int)L; { const int q = nwg / NXCD, r = nwg % NXCD, xcd = wgid % NXCD, off = wgid / NXCD; wgid = (xcd < r ? xcd * (q + 1) : r * (q + 1) + (xcd - r) * q) + off; }
        const int nig = WGM * nN, gid = wgid / nig, fm = gid * WGM, gsz = (nM - fm) < WGM ? (nM - fm) : WGM;
        u.pm = fm + ((wgid % nig) % gsz); u.pn = (wgid % nig) / gsz; return true;
    }
    __device__ __forceinline__ void a_ready(const Unit&) const {}
    __device__ __forceinline__ void done(const Unit&) const {}
};

typedef __bf16 bf16x2_t __attribute__((ext_vector_type(2)));
typedef float f32x2_t __attribute__((ext_vector_type(2)));
struct OrderOne { int pm, pn; bool on;
    __device__ __forceinline__ bool next(int i, Unit& u) const { if (i > 0 || !on) return false; u.pm = pm; u.pn = pn; return true; }
    __device__ __forceinline__ void a_ready(const Unit&) const {}
    __device__ __forceinline__ void done(const Unit&) const {}
};
__device__ __forceinline__ unsigned cvt_pk_bf16(float lo, float hi) { const f32x2_t v = {lo, hi}; return __builtin_bit_cast(unsigned, __builtin_convertvector(v, bf16x2_t)); }

struct EpiP {
    static constexpr bool PERM = true, AFTER_DRAIN = false;
    bf16_t* pa; bf16_t* pb; const float* lbl;
    __device__ __forceinline__ void operator()(const f32x4 (&acc)[2][2][4][2], const Unit& u, int wr, int wc, int fr, int fq) const {
        const int row0 = u.pm * BM + wr * 64 + fr;
        bf16_t* base; int ldc, colt;
        if (u.pn < 9) { base = pa; ldc = 2304; colt = u.pn * BM; } else { base = pb; ldc = 2560; colt = (u.pn - 9) * BM; }
        const int col0 = colt + wc * 32 + 8 * fq;
        const int ct = u.pn - 9;
        const int kind = (ct < 0) ? 0 : ((ct < 2) ? 1 : ((ct >= 4 && ct < 8) ? 2 : 0));
        float lbv[2][8];
#pragma unroll
        for (int bj = 0; bj < 2; ++bj)
#pragma unroll
            for (int j = 0; j < 8; ++j) lbv[bj][j] = 0.f;
        if (kind == 2) { const int d = (ct - 4) >> 1, cb = (ct & 1) * 256 + wc * 32 + 8 * fq;
#pragma unroll
            for (int bj = 0; bj < 2; ++bj)
#pragma unroll
                for (int j = 0; j < 8; ++j) { const int c = cb + bj * HALF + j; const float l0 = lbl[(0 * 2 + d) * 512 + c], l1 = lbl[(1 * 2 + d) * 512 + c]; lbv[bj][j] = __builtin_amdgcn_rcpf(1.f + __expf(l1 - l0)); } }
#pragma unroll
        for (int ai = 0; ai < 2; ++ai)
#pragma unroll
            for (int m = 0; m < 4; ++m) { bf16_t* rowp = base + (size_t)(row0 + ai * HALF + m * 16) * ldc + col0;
#pragma unroll
                for (int bj = 0; bj < 2; ++bj) { f32x4 v0 = acc[ai][bj][m][0], v1 = acc[ai][bj][m][1];
                    if (kind == 1) {
#pragma unroll
                        for (int j = 0; j < 4; ++j) { v0[j] = v0[j] * __builtin_amdgcn_rcpf(1.f + __expf(-v0[j])); v1[j] = v1[j] * __builtin_amdgcn_rcpf(1.f + __expf(-v1[j])); } }
                    else if (kind == 2) {
#pragma unroll
                        for (int j = 0; j < 4; ++j) { const float la = lbv[bj][j], lb2 = lbv[bj][4 + j];
                            v0[j] = __logf(la + (1.f - la) * __builtin_amdgcn_rcpf(1.f + __expf(-v0[j]))); v1[j] = __logf(lb2 + (1.f - lb2) * __builtin_amdgcn_rcpf(1.f + __expf(-v1[j]))); } }
                    u32x4 w; w.x = cvt_pk_bf16(v0[0], v0[1]); w.y = cvt_pk_bf16(v0[2], v0[3]); w.z = cvt_pk_bf16(v1[0], v1[1]); w.w = cvt_pk_bf16(v1[2], v1[3]);
                    *(u32x4*)(rowp + bj * HALF) = w; } }
    }
};
struct EpiH {
    static constexpr bool PERM = false, AFTER_DRAIN = false;
    const float* xp; const float* xs; const float* gate; bf16_t* hb; bf16_t* h2; int part;
    __device__ __forceinline__ void operator()(const f32x4 (&acc)[2][2][4][2], const Unit& u, int wr, int wc, int fr, int fq) const {
        const int row0 = u.pm * BM + wr * 64 + fr, col0 = u.pn * BM + wc * 32 + 4 * fq;
        const int modrow = (u.pm < 16) ? 0 : 1 + ((u.pm - 16) >> 3);
        f32x4 gv[2][2];
#pragma unroll
        for (int bj = 0; bj < 2; ++bj)
#pragma unroll
            for (int n = 0; n < 2; ++n) gv[bj][n] = *(const f32x4*)(gate + modrow * 1024 + col0 + bj * HALF + n * 16);
        f32x4 xb[2][2][2];
#pragma unroll
        for (int q = 0; q < 2; ++q)
#pragma unroll
            for (int bj = 0; bj < 2; ++bj)
#pragma unroll
                for (int n = 0; n < 2; ++n) xb[q][bj][n] = (f32x4){0.f, 0.f, 0.f, 0.f};
        if (!part) { const float* xrow = (u.pm < 16) ? xp + (size_t)row0 * 1024 : xs + (size_t)(row0 - 4096) * 1024;
#pragma unroll
            for (int bj = 0; bj < 2; ++bj)
#pragma unroll
                for (int n = 0; n < 2; ++n) xb[0][bj][n] = *(const f32x4*)(xrow + col0 + bj * HALF + n * 16); }
#pragma unroll
        for (int idx = 0; idx < 8; ++idx) { const int ai = idx >> 2, m = idx & 3; const int r = row0 + ai * HALF + m * 16;
            if (!part && idx + 1 < 8) { const int rn = row0 + ((idx + 1) >> 2) * HALF + ((idx + 1) & 3) * 16;
                const float* xrow = (u.pm < 16) ? xp + (size_t)rn * 1024 : xs + (size_t)(rn - 4096) * 1024;
#pragma unroll
                for (int bj = 0; bj < 2; ++bj)
#pragma unroll
                    for (int n = 0; n < 2; ++n) xb[(idx + 1) & 1][bj][n] = *(const f32x4*)(xrow + col0 + bj * HALF + n * 16); }
            bf16_t* orow = part ? h2 + (size_t)(r - 16384) * 1024 : hb + (size_t)r * 1024;
#pragma unroll
            for (int bj = 0; bj < 2; ++bj)
#pragma unroll
                for (int n = 0; n < 2; ++n) { const int c = col0 + bj * HALF + n * 16; const f32x4 hv = gv[bj][n] * acc[ai][bj][m][n] + xb[idx & 1][bj][n];
                    uint2 o; o.x = cvt_pk_bf16(hv[0], hv[1]); o.y = cvt_pk_bf16(hv[2], hv[3]); *(uint2*)(orow + c) = o; } }
    }
};

template <class Epi, class Sched>
__device__ __forceinline__ void gemm_phase(PG8_LAS unsigned char* lds, const Gemm g, const Sched& S, const Epi& E) {
    int tid = threadIdx.x; asm volatile("" : "+v"(tid)); const int wid = __builtin_amdgcn_readfirstlane(tid >> 6), lane = tid & 63, wr = wid >> 2, wc = wid & 3, fr = lane & 15, fq = lane >> 4;
    const int K = g.K, nt = K / BK, ld = g.ld;
    unsigned voffA[2], voffB[2];
#pragma unroll
    for (int i = 0; i < 2; ++i) { int R, C; stage_rc(tid * 16 + i * 8192, R, C); const int Rb = Epi::PERM ? ((R & ~31) + perm32(R & 31)) : R;
        voffA[i] = (unsigned)(R * ld + C) * 2u; voffB[i] = (unsigned)(Rb * ld + C) * 2u; }
    const size_t kstep = (size_t)(BK * 2);
    const size_t hstep = (size_t)HALF * ld * 2;
    const size_t tstep = 2 * hstep;
    const unsigned ldsw = (unsigned)wid * 1024u;
    const int aoff = lds_byte(wr * 64 + fr, fq * 8), boff = lds_byte(wc * 32 + fr, fq * 8);
#define PG8_SA(b, h) (((b) * 2 + (h)) * HTB)
#define PG8_SB(b, h) ((4 + (b) * 2 + (h)) * HTB)
#define PG8_STAGE(bufoff, gbase, voff) do { _Pragma("unroll") for (int _i = 0; _i < 2; ++_i) \
        __builtin_amdgcn_global_load_lds((const unsigned*)((const char*)(gbase) + (voff)[_i]), (PG8_LAS unsigned*)(lds + (bufoff) + ldsw + _i * 8192), 16, 0, 0); } while (0)
#define PG8_LDA(dst, b, h) do { _Pragma("unroll") for (int m = 0; m < 4; ++m) _Pragma("unroll") for (int k = 0; k < 2; ++k) dst[m][k] = *(const PG8_LAS bf16x8*)(lds + PG8_SA(b, h) + aoff + m * 2048 + k * 1024); } while (0)
#define PG8_LDB(dst, b, h) do { _Pragma("unroll") for (int n = 0; n < 2; ++n) _Pragma("unroll") for (int k = 0; k < 2; ++k) dst[n][k] = *(const PG8_LAS bf16x8*)(lds + PG8_SB(b, h) + boff + n * 2048 + k * 1024); } while (0)
#define PG8_MMA(ai, bj, At, Bt) do { __builtin_amdgcn_s_setprio(1); _Pragma("unroll") for (int m = 0; m < 4; ++m) _Pragma("unroll") for (int n = 0; n < 2; ++n) _Pragma("unroll") for (int k = 0; k < 2; ++k) \
        acc[ai][bj][m][n] = __builtin_amdgcn_mfma_f32_16x16x32_bf16(Bt[n][k], At[m][k], acc[ai][bj][m][n], 0, 0, 0); __builtin_amdgcn_s_setprio(0); } while (0)
#define PG8_WAIT_V(n) asm volatile("s_waitcnt vmcnt(" #n ")" ::: "memory")
#define PG8_WAIT_L(n) asm volatile("s_waitcnt lgkmcnt(" #n ")" ::: "memory")
#define PG8_BAR __builtin_amdgcn_s_barrier()
#define PG8_SCHED __builtin_amdgcn_sched_barrier(0)
    Unit cur, nxt; int ui = 0;
    if (!S.next(0, cur)) return;
    f32x4 acc[2][2][4][2];
#pragma unroll
    for (int a = 0; a < 2; ++a)
#pragma unroll
        for (int b = 0; b < 2; ++b)
#pragma unroll
            for (int m = 0; m < 4; ++m)
#pragma unroll
                for (int n = 0; n < 2; ++n) acc[a][b][m][n] = (f32x4){0.f, 0.f, 0.f, 0.f};
    bf16x8 At[4][2], B0[2][2], B1[2][2];
    const char* cA = (const char*)g.A + (size_t)cur.pm * tstep; const char* cB = (const char*)g.Bt + (size_t)cur.pn * tstep;
    S.a_ready(cur);
    PG8_STAGE(PG8_SB(0, 0), cB, voffB); PG8_STAGE(PG8_SA(0, 0), cA, voffA); PG8_STAGE(PG8_SB(0, 1), cB + hstep, voffB); PG8_STAGE(PG8_SA(0, 1), cA + hstep, voffA);
    if (wr == 1) PG8_BAR;
    PG8_WAIT_V(4); PG8_BAR;
    PG8_STAGE(PG8_SB(1, 0), cB + kstep, voffB); PG8_STAGE(PG8_SA(1, 0), cA + kstep, voffA); PG8_STAGE(PG8_SB(1, 1), cB + hstep + kstep, voffB);
    PG8_WAIT_V(6); PG8_BAR;
    for (;;) {
        const bool has_next = S.next(ui + 1, nxt);
        const char* nA = has_next ? (const char*)g.A + (size_t)nxt.pm * tstep : cA; const char* nB = has_next ? (const char*)g.Bt + (size_t)nxt.pn * tstep : cB;
        for (int t = 0; t < nt; t += 2) {
            const bool last = (t == nt - 2);
            const char* a1 = cA + (size_t)(t + 1) * kstep;
            const char* a2 = last ? nA : cA + (size_t)(t + 2) * kstep; const char* b2 = last ? nB : cB + (size_t)(t + 2) * kstep;
            const char* a3 = a2 + kstep; const char* b3 = b2 + kstep;
            if (last && has_next) S.a_ready(nxt);
            PG8_LDB(B0, 0, 0); PG8_SCHED; PG8_LDA(At, 0, 0); PG8_STAGE(PG8_SA(1, 1), a1 + hstep, voffA);
            PG8_WAIT_L(8); PG8_BAR; PG8_WAIT_L(0); PG8_MMA(0, 0, At, B0); PG8_BAR; PG8_SCHED;
            PG8_LDB(B1, 0, 1); PG8_STAGE(PG8_SB(0, 0), b2, voffB);
            PG8_BAR; PG8_WAIT_L(0); PG8_MMA(0, 1, At, B1); PG8_BAR;
            PG8_LDA(At, 0, 1); PG8_STAGE(PG8_SA(0, 0), a2, voffA);
            PG8_BAR; PG8_WAIT_L(0); PG8_MMA(1, 0, At, B0); PG8_BAR; PG8_SCHED;
            PG8_STAGE(PG8_SB(0, 1), b2 + hstep, voffB);
            PG8_WAIT_V(6); PG8_BAR; PG8_MMA(1, 1, At, B1); PG8_BAR;
            PG8_LDB(B0, 1, 0); PG8_SCHED; PG8_LDA(At, 1, 0); PG8_STAGE(PG8_SA(0, 1), a2 + hstep, voffA);
            PG8_WAIT_L(8); PG8_BAR; PG8_WAIT_L(0); PG8_MMA(0, 0, At, B0); PG8_BAR; PG8_SCHED;
            PG8_LDB(B1, 1, 1); PG8_STAGE(PG8_SB(1, 0), b3, voffB);
            PG8_BAR; PG8_WAIT_L(0); PG8_MMA(0, 1, At, B1); PG8_BAR;
            PG8_LDA(At, 1, 1); PG8_STAGE(PG8_SA(1, 0), a3, voffA);
            PG8_BAR; PG8_WAIT_L(0); PG8_MMA(1, 0, At, B0); PG8_BAR; PG8_SCHED;
            PG8_STAGE(PG8_SB(1, 1), b3 + hstep, voffB);
            PG8_WAIT_V(6); PG8_BAR; PG8_MMA(1, 1, At, B1); PG8_BAR;
        }
        E(acc, cur, wr, wc, fr, fq); S.done(cur);
        if (!has_next) break;
#pragma unroll
        for (int a = 0; a < 2; ++a)
#pragma unroll
            for (int b = 0; b < 2; ++b)
#pragma unroll
                for (int m = 0; m < 4; ++m)
#pragma unroll
                    for (int n = 0; n < 2; ++n) acc[a][b][m][n] = (f32x4){0.f, 0.f, 0.f, 0.f};
        cur = nxt; cA = nA; cB = nB; ++ui;
    }
    PG8_WAIT_V(0);
    if (wr == 0) PG8_BAR;
    PG8_BAR;
#undef PG8_SA
#undef PG8_SB
#undef PG8_STAGE
#undef PG8_LDA
#undef PG8_LDB
#undef PG8_MMA
#undef PG8_WAIT_V
#undef PG8_WAIT_L
#undef PG8_BAR
#undef PG8_SCHED
}
}

using pg8::bf16_t; using pg8::bf16x8; using pg8::f32x4; using pg8::u32x4; using pg8::cvt_pk_bf16;

constexpr int NTOK = 20480, NPTOK = 4096;
constexpr int LDS_BYTES = 159744;
constexpr size_t OUT_Y = (size_t)NTOK * 1024;
constexpr size_t OUT_SA = OUT_Y;
constexpr size_t OUT_SB = OUT_Y + 1048576;
constexpr size_t WS_MODP = 0;
constexpr size_t WS_GATE = 884736;
constexpr size_t WS_BON = 921600;
constexpr size_t WS_WTOUT = 2359296;
constexpr size_t WS_XM = WS_WTOUT + 2097152;
constexpr size_t WS_PB = WS_XM + 41943040;
constexpr size_t WS_PA = WS_PB + 104857600;
constexpr size_t WS_WTIN = WS_PA + 94371840;
constexpr size_t WS_BAR = WS_WTIN + 20971520;
constexpr size_t WS_END = WS_BAR + 16384;

struct Params {
    const float *x_prompt, *x_sample, *state_rwkv, *state_hgrn, *c, *c_ctx, *norm_g, *w_ada, *b_ada, *w_in, *mu_h, *mu_v, *w0, *w2, *a0, *a2, *k_k, *k_a, *r_k,
                *lnx_w, *lnx_b, *lb_logits, *onorm_g, *w_out, *final_g;
    float* out;
    float* modp; float* gate; float* bon; bf16_t* wt_in; bf16_t* wt_out; bf16_t* xm; bf16_t* pa; bf16_t* pb; bf16_t* zs;
    unsigned* bar;
    int ph_lo, ph_hi;
};

__device__ __forceinline__ float bf2f(bf16_t h) { return __uint_as_float(((unsigned)h) << 16); }
__device__ __forceinline__ bf16_t f2bf(float f) { return __builtin_bit_cast(unsigned short, (__bf16)f); }
__device__ __forceinline__ float wave_sum(float v) {
#pragma unroll
    for (int o = 1; o < 64; o <<= 1) v += __shfl_xor(v, o);
    return v;
}
template <int CTRL> __device__ __forceinline__ float dppf(float x) { return __int_as_float(__builtin_amdgcn_update_dpp(0, __float_as_int(x), CTRL, 0xf, 0xf, true)); }
__device__ __forceinline__ float red8(float x) { x += dppf<0xB1>(x); x += dppf<0x4E>(x); x += dppf<0x141>(x); return x; }
__device__ __forceinline__ float red16(float x) { x = red8(x); x += dppf<0x140>(x); return x; }
__device__ __forceinline__ float wave_sum_fast(float x) {
    x = red16(x);
    const float a = __builtin_amdgcn_readlane(x, 0), b = __builtin_amdgcn_readlane(x, 16), c = __builtin_amdgcn_readlane(x, 32), d = __builtin_amdgcn_readlane(x, 48);
    return (a + b) + (c + d);
}
__device__ __forceinline__ float sigmoidf_(float x) { return __builtin_amdgcn_rcpf(1.f + __expf(-x)); }
__device__ __forceinline__ void unpack8(const u32x4 w, float* x) {
    x[0] = __uint_as_float(w.x << 16); x[1] = __uint_as_float(w.x & 0xffff0000u); x[2] = __uint_as_float(w.y << 16); x[3] = __uint_as_float(w.y & 0xffff0000u);
    x[4] = __uint_as_float(w.z << 16); x[5] = __uint_as_float(w.z & 0xffff0000u); x[6] = __uint_as_float(w.w << 16); x[7] = __uint_as_float(w.w & 0xffff0000u);
}
__device__ __forceinline__ int otid() { int t = threadIdx.x; asm volatile("" : "+v"(t)); return t; }
__device__ __forceinline__ void ld8f(const float* p, float* x) { const float4 a = *(const float4*)p, b = *(const float4*)(p + 4); x[0] = a.x; x[1] = a.y; x[2] = a.z; x[3] = a.w; x[4] = b.x; x[5] = b.y; x[6] = b.z; x[7] = b.w; }
__device__ __forceinline__ void lds_fence_wave() { asm volatile("s_waitcnt lgkmcnt(0)" ::: "memory"); __builtin_amdgcn_wave_barrier(); }

__device__ __forceinline__ void transpose_item(const float* __restrict__ W, int K, int N, bf16_t* __restrict__ WT, float* scr, int item, int lane) {
    const int nblk = N / 32, kb = item / nblk, nb = item % nblk, k0 = 64 * kb, n0 = 32 * nb;
#pragma unroll 8
    for (int i = 0; i < 32; ++i) { const int kk = 2 * i + (lane >> 5); scr[kk * 33 + (lane & 31)] = W[(size_t)(k0 + kk) * N + n0 + (lane & 31)]; }
    lds_fence_wave();
    const int c = lane & 7;
#pragma unroll
    for (int j = 0; j < 4; ++j) { const int n = (lane >> 3) + 8 * j; const float* s = scr + (8 * c) * 33 + n;
        u32x4 o; o.x = cvt_pk_bf16(s[0 * 33], s[1 * 33]); o.y = cvt_pk_bf16(s[2 * 33], s[3 * 33]); o.z = cvt_pk_bf16(s[4 * 33], s[5 * 33]); o.w = cvt_pk_bf16(s[6 * 33], s[7 * 33]);
        *(u32x4*)(WT + (size_t)(n0 + n) * K + k0 + 8 * c) = o; }
    lds_fence_wave();
}

__device__ __forceinline__ void phase0(const Params& p, unsigned char* smem) {
    const int tid = otid(), lane = tid & 63, wave = tid >> 6;
    const int gw = blockIdx.x * 8 + wave, NGW = gridDim.x * 8;
    float* sl = (float*)smem;
    float* scr = (float*)(smem + 49152) + wave * (64 * 33);
    if ((int)blockIdx.x * 8 < 384) {
        for (int e = tid; e < 9 * 1024; e += 512) { const int j = e >> 10, k = e & 1023; const float cv = (j == 0) ? p.c_ctx[k] : p.c[(j - 1) * 1024 + k]; sl[k * 12 + j] = cv / (1.f + __expf(-cv)); }
        __syncthreads();
        if (gw < 384) {
            const int cb = gw % 48, kc = gw / 48, col = cb * 64 + lane;
            float a0 = 0, a1 = 0, a2 = 0, a3 = 0, a4 = 0, a5 = 0, a6 = 0, a7 = 0, a8 = 0;
#pragma unroll 16
            for (int k = kc * 128; k < kc * 128 + 128; ++k) {
                const float wv = p.w_ada[(size_t)k * 3072 + col];
                const float4* s4 = (const float4*)(sl + k * 12); const float4 s0 = s4[0], s1 = s4[1], s2 = s4[2];
                a0 += s0.x * wv; a1 += s0.y * wv; a2 += s0.z * wv; a3 += s0.w * wv; a4 += s1.x * wv; a5 += s1.y * wv; a6 += s1.z * wv; a7 += s1.w * wv; a8 += s2.x * wv;
            }
            float* mp = p.modp + (size_t)kc * 9 * 3072 + col;
            mp[0 * 3072] = a0; mp[1 * 3072] = a1; mp[2 * 3072] = a2; mp[3 * 3072] = a3; mp[4 * 3072] = a4; mp[5 * 3072] = a5; mp[6 * 3072] = a6; mp[7 * 3072] = a7; mp[8 * 3072] = a8;
        }
    }
    for (int it = gw; it < 2432 + 512; it += NGW) {
        if (it < 2432) transpose_item(p.w_in, 1024, 4864, p.wt_in, scr, it, lane);
        else transpose_item(p.w_out, 1024, 1024, p.wt_out, scr, it - 2432, lane);
    }
}

__device__ __forceinline__ void phase1(const Params& p, unsigned char* smem) {
    const int tid = otid(), lane = tid & 63, wave = tid >> 6;
    float* gs = (float*)smem; float* sh = gs + 1024;
    if (blockIdx.x < 9) {
        const int row = blockIdx.x;
        for (int c = tid; c < 1024; c += 512) { float s = p.b_ada[2048 + c];
#pragma unroll
            for (int kc = 0; kc < 8; ++kc) s += p.modp[((size_t)kc * 9 + row) * 3072 + 2048 + c];
            p.gate[row * 1024 + c] = s; }
    }
    const int G = gridDim.x, per = (2560 + G - 1) / G; const int g0 = blockIdx.x * per, g1 = (g0 + per) < 2560 ? (g0 + per) : 2560;
    int cur = -1;
    for (int grp = g0; grp < g1; ++grp) {
        const int tok0 = grp * 8; const int row = tok0 < NPTOK ? 0 : 1 + ((tok0 - NPTOK) >> 11);
        if (row != cur) {
            __syncthreads();
            for (int c = tid; c < 1024; c += 512) { float s0 = p.b_ada[c], s1 = p.b_ada[1024 + c];
#pragma unroll
                for (int kc = 0; kc < 8; ++kc) { s0 += p.modp[((size_t)kc * 9 + row) * 3072 + c]; s1 += p.modp[((size_t)kc * 9 + row) * 3072 + 1024 + c]; }
                gs[c] = p.norm_g[c] * (1.f + s1); sh[c] = s0; }
            __syncthreads(); cur = row;
        }
        const bool two = (grp + 1 < g1) && ((tok0 + 8 < NPTOK ? 0 : 1 + ((tok0 + 8 - NPTOK) >> 11)) == row);
        const int tokA = tok0 + wave, tokB = two ? tokA + 8 : tokA;
        const float* xa = tokA < NPTOK ? p.x_prompt + (size_t)tokA * 1024 : p.x_sample + (size_t)(tokA - NPTOK) * 1024;
        const float* xb = tokB < NPTOK ? p.x_prompt + (size_t)tokB * 1024 : p.x_sample + (size_t)(tokB - NPTOK) * 1024;
        float4 va[4], vb[4]; float sa = 0.f, sb = 0.f;
#pragma unroll
        for (int j = 0; j < 4; ++j) { va[j] = ((const float4*)xa)[lane + 64 * j]; vb[j] = ((const float4*)xb)[lane + 64 * j]; }
#pragma unroll
        for (int j = 0; j < 4; ++j) { sa += va[j].x * va[j].x + va[j].y * va[j].y + va[j].z * va[j].z + va[j].w * va[j].w; sb += vb[j].x * vb[j].x + vb[j].y * vb[j].y + vb[j].z * vb[j].z + vb[j].w * vb[j].w; }
        sa = wave_sum_fast(sa); sb = wave_sum_fast(sb);
        const float ra = rsqrtf(sa * (1.f / 1024.f) + 1e-6f), rb = rsqrtf(sb * (1.f / 1024.f) + 1e-6f);
#pragma unroll
        for (int j = 0; j < 4; ++j) { const int c = 4 * (lane + 64 * j); const float4 g4 = *(const float4*)(gs + c), h4 = *(const float4*)(sh + c);
            uint2 o; o.x = cvt_pk_bf16(va[j].x * ra * g4.x + h4.x, va[j].y * ra * g4.y + h4.y); o.y = cvt_pk_bf16(va[j].z * ra * g4.z + h4.z, va[j].w * ra * g4.w + h4.w);
            *(uint2*)(p.xm + (size_t)tokA * 1024 + c) = o;
            if (two) { uint2 o2; o2.x = cvt_pk_bf16(vb[j].x * rb * g4.x + h4.x, vb[j].y * rb * g4.y + h4.y); o2.y = cvt_pk_bf16(vb[j].z * rb * g4.z + h4.z, vb[j].w * rb * g4.w + h4.w);
                *(uint2*)(p.xm + (size_t)tokB * 1024 + c) = o2; } }
        if (two) ++grp;
    }
}

__device__ __forceinline__ void phase3(const Params& p) {
    const int tid = otid(), lane = tid & 63, wave = tid >> 6;
    const int gw = blockIdx.x * 8 + wave, NGW = gridDim.x * 8;
    bf16_t* PS = (bf16_t*)p.out;
    for (int item = gw; item < NTOK * 288 / 64; item += NGW) {
        const int idx = item * 64 + lane, tok = idx / 288, col = (idx - tok * 288) * 8;
        const bool grid = tok >= NPTOK; const int t = grid ? (tok - NPTOK) & 2047 : tok & 255;
        bool hp, hn, vu = false, vd = false;
        if (!grid) { hp = t > 0; hn = t < 255; } else { const int cgx = t & 63, rgy = t >> 6; hp = cgx > 0; hn = cgx < 63; vu = rgy > 0; vd = rgy < 31; }
        const bf16_t* pc = p.pa + (size_t)tok * 2304 + col;
        const u32x4 c0 = *(const u32x4*)pc, c1 = *(const u32x4*)(pc + (hp ? -2304 : 0)), c2 = *(const u32x4*)(pc + (hn ? 2304 : 0));
        const u32x4 c3 = *(const u32x4*)(pc + (vu ? -64 * 2304 : 0)), c4 = *(const u32x4*)(pc + (vd ? 64 * 2304 : 0));
        float mh[8], mv[8]; ld8f(p.mu_h + col, mh); ld8f(p.mu_v + col, mv);
        const float whp = hp ? 0.5f : 0.f, whn = hn ? 0.5f : 0.f, wvu = vu ? 0.5f : 0.f, wvd = vd ? 0.5f : 0.f, gsel = grid ? 1.f : 0.f;
        float x[8], xa[8], xb[8], res[8];
        unpack8(c0, x); unpack8(c1, xa); unpack8(c2, xb);
#pragma unroll
        for (int j = 0; j < 8; ++j) res[j] = x[j] + mh[j] * (whp * xa[j] + whn * xb[j] - x[j]);
        unpack8(c3, xa); unpack8(c4, xb);
#pragma unroll
        for (int j = 0; j < 8; ++j) res[j] += gsel * mv[j] * (wvu * xa[j] + wvd * xb[j] - x[j]);
        const bool is_za = (col >= 1536 && col < 2048), is_wl = (col >= 2048 && ((col - 2048) & 64) == 0);
        if (is_wl) {
#pragma unroll
            for (int j = 0; j < 8; ++j) { const float e2 = __expf(2.f * res[j]); res[j] = 1.f - 2.f * __builtin_amdgcn_rcpf(e2 + 1.f); } }
        if (is_za) {
#pragma unroll
            for (int j = 0; j < 8; ++j) res[j] = res[j] * sigmoidf_(res[j]); }
        u32x4 o; o.x = cvt_pk_bf16(res[0], res[1]); o.y = cvt_pk_bf16(res[2], res[3]); o.z = cvt_pk_bf16(res[4], res[5]); o.w = cvt_pk_bf16(res[6], res[7]);
        bf16_t* dst = is_za ? (p.zs + (size_t)tok * 512 + (col - 1536)) : (PS + (size_t)tok * 1792 + (col < 1536 ? col : col - 512));
        *(u32x4*)dst = o;
    }
}

typedef short s16x4 __attribute__((ext_vector_type(4)));
__device__ __forceinline__ s16x4 pack4(const f32x4 v) { uint2 r; r.x = cvt_pk_bf16(v[0], v[1]); r.y = cvt_pk_bf16(v[2], v[3]); return __builtin_bit_cast(s16x4, r); }
#define MFMA16(a, b, c) __builtin_amdgcn_mfma_f32_16x16x16bf16_1k((a), (b), (c), 0, 0, 0)
__device__ __forceinline__ void rwkv_item(const Params& p, unsigned char* smem, int seq, int d, int h) {
    const int tid = otid(), lane = tid & 63, wave = tid >> 6;
    const bool grid = seq >= 16; const int T = grid ? 2048 : 256; const int g0 = grid ? NPTOK + (seq - 16) * 2048 : seq * 256; const int bidx = grid ? seq - 16 : seq;
    float* RF = (float*)(smem + 0);
    float* KEF = (float*)(smem + 8192);
    float* EF = (float*)(smem + 16384);
    float* KAP = (float*)(smem + 24576);
    float* BF = (float*)(smem + 32768);
    bf16_t* VTb0 = (bf16_t*)(smem + 40960);
    bf16_t* LWb = (bf16_t*)(smem + 51200);
    bf16_t* QH0 = (bf16_t*)(smem + 60416);
    bf16_t* BK = (bf16_t*)(smem + 78848);
    bf16_t* KP0 = (bf16_t*)(smem + 88064);
    bf16_t* AMs0 = (bf16_t*)(smem + 108544);
    float* G150 = (float*)(smem + 122880);
    float* YOUT0 = (float*)(smem + 123904);
    float* BONL = (float*)(smem + 140288);
    bf16_t* WL = (bf16_t*)(smem + 140672);
    const int nmc = T / 32;
    bf16_t* YA = p.pa + (size_t)d * NTOK * 512;
    const bf16_t* PS = (const bf16_t*)p.out;
    float* BON = p.bon + (size_t)d * NTOK * 8;
    const int lr = lane & 15, lq = lane >> 4;

    f32x4 Lacc = {0.f, 0.f, 0.f, 0.f};
    f32x4 ST[4];
#pragma unroll
    for (int kt = 0; kt < 4; ++kt) ST[kt] = (f32x4){0.f, 0.f, 0.f, 0.f};
    if (wave < 4 && grid) { const float* st = p.state_rwkv + ((size_t)(bidx * 2 + d) * 8 + h) * 4096 + (16 * wave + lr) * 64;
#pragma unroll
        for (int kt = 0; kt < 4; ++kt) { const float4 s4 = *(const float4*)(st + 16 * kt + 4 * lq); ST[kt] = (f32x4){s4.x, s4.y, s4.z, s4.w}; } }
    for (int e = tid; e < 2 * 64 * 64; e += 512) { const int ty = e >> 12, k = (e >> 6) & 63, n = e & 63;
        const float wv = ty ? p.a2[(size_t)(d * 64 + k) * 512 + 64 * h + n] : p.w2[(size_t)(d * 64 + k) * 512 + 64 * h + n];
        WL[(ty * 64 + n) * 72 + k] = f2bf(wv); }
    const float ka3 = p.k_a[64 * h + (tid & 63)];
    float kq[8]; ld8f(p.k_k + 64 * h + (tid & 7) * 8, kq);
    float w0c = 0.f, a0c = 0.f, kac = 0.f, rkc = 0.f;
    { const int n = 64 * h + 16 * (wave & 3) + lr; w0c = p.w0[d * 512 + n]; a0c = p.a0[d * 512 + n]; kac = p.k_a[n]; rkc = p.r_k[n]; }

    u32x4 L[3];
#pragma unroll
    for (int m = 0; m < 3; ++m) L[m] = (u32x4){0u, 0u, 0u, 0u};
    auto A_load = [&](int c) {
#pragma unroll
        for (int m = 0; m < 3; ++m) { const int it = tid + 512 * m;
            if (it < 1280) { const int grp = it >> 8, i = (it >> 3) & 31, v8 = it & 7;
                const int col = (grp < 3 ? grp * 512 + 64 * h : 1536 + 128 * d + (grp - 3) * 64) + v8 * 8;
                const int step = c * 32 + i, t = d ? T - 1 - step : step;
                L[m] = *(const u32x4*)(PS + (size_t)(g0 + t) * 1792 + col); } }
    };
    auto prep = [&](int c) {
        const int par = c & 1;
        bf16_t* VTb = VTb0 + par * 2560; bf16_t* QH = QH0 + par * 4608; bf16_t* KP = KP0 + par * 5120; bf16_t* AMs = AMs0 + par * 2560; float* G15 = G150 + par * 128;
        float* BONc = BONL + (c % 3) * 32;
        __builtin_amdgcn_s_waitcnt(0);
        if (tid < 32) BONc[tid] = 0.f;
#pragma unroll
        for (int m = 0; m < 3; ++m) { const int it = tid + 512 * m;
            if (it < 1280) { const int grp = __builtin_amdgcn_readfirstlane(it >> 8), i = (it >> 3) & 31, v8 = it & 7;
                const int cc = v8 * 8; const u32x4 w = L[m];
                if (grp < 2) { float res[8]; unpack8(w, res); float* dst = RF + grp * 2048 + i * 64 + cc;
                    *(float4*)dst = make_float4(res[0], res[1], res[2], res[3]); *(float4*)(dst + 4) = make_float4(res[4], res[5], res[6], res[7]);
                    if (grp == 1) {
                        float ss = 0.f;
#pragma unroll
                        for (int j = 0; j < 8; ++j) { res[j] *= kq[j]; ss += res[j] * res[j]; }
                        ss = red8(ss);
                        const float inv = __builtin_amdgcn_rcpf(fmaxf(__builtin_amdgcn_sqrtf(ss), 1e-12f));
                        *(float4*)(KAP + i * 64 + cc) = make_float4(res[0] * inv, res[1] * inv, res[2] * inv, res[3] * inv); *(float4*)(KAP + i * 64 + cc + 4) = make_float4(res[4] * inv, res[5] * inv, res[6] * inv, res[7] * inv); }
                } else if (grp == 2) {
                    VTb[(cc + 0) * 40 + i] = (bf16_t)(w.x & 0xffffu); VTb[(cc + 1) * 40 + i] = (bf16_t)(w.x >> 16); VTb[(cc + 2) * 40 + i] = (bf16_t)(w.y & 0xffffu); VTb[(cc + 3) * 40 + i] = (bf16_t)(w.y >> 16);
                    VTb[(cc + 4) * 40 + i] = (bf16_t)(w.z & 0xffffu); VTb[(cc + 5) * 40 + i] = (bf16_t)(w.z >> 16); VTb[(cc + 6) * 40 + i] = (bf16_t)(w.w & 0xffffu); VTb[(cc + 7) * 40 + i] = (bf16_t)(w.w >> 16);
                } else {
                    *(u32x4*)(LWb + (grp - 3) * 2304 + i * 72 + cc) = w;
                } } }
        if (c + 1 < nmc) A_load(c + 1);
        __syncthreads();
        { const int wn = wave & 3, u = wave >> 2, n = 16 * wn + lr;
            f32x4 accw = {0.f, 0.f, 0.f, 0.f}, acca = {0.f, 0.f, 0.f, 0.f};
#pragma unroll
            for (int q = 0; q < 2; ++q) {
                const bf16x8 aw = *(const bf16x8*)(LWb + (16 * u + lr) * 72 + q * 32 + lq * 8);
                const bf16x8 aa = *(const bf16x8*)(LWb + 2304 + (16 * u + lr) * 72 + q * 32 + lq * 8);
                const bf16x8 bw = *(const bf16x8*)(WL + (16 * wn + lr) * 72 + q * 32 + lq * 8);
                const bf16x8 ba = *(const bf16x8*)(WL + (64 + 16 * wn + lr) * 72 + q * 32 + lq * 8);
                accw = __builtin_amdgcn_mfma_f32_16x16x32_bf16(aw, bw, accw, 0, 0, 0);
                acca = __builtin_amdgcn_mfma_f32_16x16x32_bf16(aa, ba, acca, 0, 0, 0);
            }
            float ee[4], av[4];
#pragma unroll
            for (int j = 0; j < 4; ++j) { ee[j] = __builtin_amdgcn_rcpf(1.f + __expf(-(w0c + accw[j]))) * 0.60653066f; av[j] = __builtin_amdgcn_rcpf(1.f + __expf(-(a0c + acca[j]))); }
            const float p1 = ee[0] + ee[1], p2 = p1 + ee[2], q4 = p2 + ee[3];
            const float t1 = __shfl_up(q4, 16); const float s1 = q4 + (lq >= 1 ? t1 : 0.f);
            const float t2 = __shfl_up(s1, 32); const float s2 = s1 + (lq >= 2 ? t2 : 0.f);
            const float etot = __shfl(s2, 48 + lr), offp = s2 - q4;
            const float Gtot = __expf(-etot); float Gprev = __expf(-offp), E = offp;
            float kpk[4], kpb[4];
#pragma unroll
            for (int j = 0; j < 4; ++j) { const int tau = 4 * lq + j, i = 16 * u + tau;
                E += ee[j];
                const float Gm1 = Gprev, G = __expf(-E), iG = __builtin_amdgcn_rcpf(G), tail = iG * Gtot; Gprev = G;
                const float kap = KAP[i * 64 + n], r = RF[i * 64 + n], a = av[j]; const float ke = KEF[i * 64 + n] * (1.f + (a - 1.f) * kac), b = kap * a;
                QH[(u * 32 + tau) * 72 + n] = f2bf(kap * Gm1); QH[(u * 32 + 16 + tau) * 72 + n] = f2bf(r * G);
                BK[(u * 32 + tau) * 72 + n] = f2bf(b * iG); BK[(u * 32 + 16 + tau) * 72 + n] = f2bf(ke * iG);
                kpk[j] = ke * tail; kpb[j] = b * tail;
                float pbn = 0.5f * r * ke * rkc; pbn = red16(pbn);
                if (lr == 0) atomicAdd(&BONc[i], pbn); }
            { uint2 o; o.x = cvt_pk_bf16(kpk[0], kpk[1]); o.y = cvt_pk_bf16(kpk[2], kpk[3]); *(uint2*)(KP + ((u * 2 + 0) * 64 + n) * 20 + 4 * lq) = o;
              uint2 o2; o2.x = cvt_pk_bf16(kpb[0], kpb[1]); o2.y = cvt_pk_bf16(kpb[2], kpb[3]); *(uint2*)(KP + ((u * 2 + 1) * 64 + n) * 20 + 4 * lq) = o2; }
            if (lq == 3) G15[u * 64 + n] = Gtot;
        }
        __syncthreads();
    };
    auto S4 = [&](int c) {
        const int par = c & 1; const bf16_t* QH = QH0 + par * 4608; bf16_t* AMs = AMs0 + par * 2560;
        { int u, mi, ni;
          if (wave == 4 || wave == 5) { u = wave - 4; mi = 0; ni = 0; }
          else { const int idx = wave < 4 ? wave : wave - 2; u = idx / 3; const int r3 = idx - 3 * u; mi = (r3 == 0) ? 0 : 1; ni = (r3 == 1) ? 0 : 1; }
          f32x4 acc = {0.f, 0.f, 0.f, 0.f};
#pragma unroll
          for (int q = 0; q < 2; ++q) { const bf16x8 A = *(const bf16x8*)(QH + (u * 32 + 16 * mi + lr) * 72 + q * 32 + lq * 8); const bf16x8 B = *(const bf16x8*)(BK + (u * 32 + 16 * ni + lr) * 72 + q * 32 + lq * 8);
              acc = __builtin_amdgcn_mfma_f32_16x16x32_bf16(A, B, acc, 0, 0, 0); }
          if (wave == 4 || wave == 5) Lacc = acc;
          else {
#pragma unroll
              for (int j = 0; j < 4; ++j) { const int t = lq * 4 + j, sidx = lr;
                  const int mat = (mi == 0) ? 1 : (ni == 1 ? 2 : 3); const bool keep = (mi == 0) ? (sidx < t) : (sidx <= t);
                  AMs[((u * 4 + mat) * 16 + t) * 20 + sidx] = f2bf(keep ? acc[j] : 0.f); } } }
    };
    auto S5 = [&](int c) {
        bf16_t* AMs = AMs0 + (c & 1) * 2560;
        const int u = wave - 4, cI = lr;
        float x[16];
#pragma unroll
        for (int t = 0; t < 16; ++t) x[t] = (t == cI) ? 1.f : 0.f;
#pragma unroll
        for (int sidx = 0; sidx < 15; ++sidx) {
#pragma unroll
            for (int t = sidx + 1; t < 16; ++t) { const float l = __int_as_float(__builtin_amdgcn_readlane(__float_as_int(Lacc[t & 3]), 16 * (t >> 2) + sidx)); x[t] -= l * x[sidx]; } }
        if (lq == 0) {
#pragma unroll
            for (int t = 0; t < 16; ++t) AMs[((u * 4 + 0) * 16 + t) * 20 + cI] = f2bf(-x[t]); }
    };
    auto S6 = [&](int c) {
        const int par = c & 1;
        const bf16_t* VTb = VTb0 + par * 2560; const bf16_t* QH = QH0 + par * 4608; const bf16_t* KP = KP0 + par * 5120; const bf16_t* AMs = AMs0 + par * 2560; const float* G15 = G150 + par * 128;
        float* YOUT = YOUT0 + par * 2048;
#pragma unroll 1
        for (int u = 0; u < 2; ++u) {
            s16x4 STb[4];
#pragma unroll
            for (int kt = 0; kt < 4; ++kt) STb[kt] = pack4(ST[kt]);
            f32x4 W = {0.f, 0.f, 0.f, 0.f}, RS = {0.f, 0.f, 0.f, 0.f};
#pragma unroll
            for (int kt = 0; kt < 4; ++kt) { const s16x4 ak = *(const s16x4*)(QH + (u * 32 + lr) * 72 + 16 * kt + 4 * lq); const s16x4 ar = *(const s16x4*)(QH + (u * 32 + 16 + lr) * 72 + 16 * kt + 4 * lq);
                W = MFMA16(ak, STb[kt], W); RS = MFMA16(ar, STb[kt], RS); }
            const s16x4 Vb = *(const s16x4*)(VTb + (16 * wave + lr) * 40 + 16 * u + 4 * lq);
            const s16x4 aTi = *(const s16x4*)(AMs + ((u * 4 + 0) * 16 + lr) * 20 + 4 * lq), aKk = *(const s16x4*)(AMs + ((u * 4 + 1) * 16 + lr) * 20 + 4 * lq);
            const s16x4 aKr = *(const s16x4*)(AMs + ((u * 4 + 2) * 16 + lr) * 20 + 4 * lq), aBr = *(const s16x4*)(AMs + ((u * 4 + 3) * 16 + lr) * 20 + 4 * lq);
            const f32x4 Z = MFMA16(aKk, Vb, W);
            const s16x4 Zb = pack4(Z);
            const f32x4 zero = {0.f, 0.f, 0.f, 0.f};
            const f32x4 U = MFMA16(aTi, Zb, zero);
            const s16x4 Ub = pack4(U);
            f32x4 Y = MFMA16(aKr, Vb, RS); Y = MFMA16(aBr, Ub, Y);
#pragma unroll
            for (int j = 0; j < 4; ++j) YOUT[(16 * u + 4 * lq + j) * 64 + 16 * wave + lr] = Y[j];
#pragma unroll
            for (int kt = 0; kt < 4; ++kt) { const float4 g4 = *(const float4*)(G15 + u * 64 + 16 * kt + 4 * lq);
                f32x4 sv = ST[kt]; sv[0] *= g4.x; sv[1] *= g4.y; sv[2] *= g4.z; sv[3] *= g4.w;
                const s16x4 akp = *(const s16x4*)(KP + ((u * 2 + 0) * 64 + 16 * kt + lr) * 20 + 4 * lq), abp = *(const s16x4*)(KP + ((u * 2 + 1) * 64 + 16 * kt + lr) * 20 + 4 * lq);
                sv = MFMA16(akp, Vb, sv); sv = MFMA16(abp, Ub, sv); ST[kt] = sv; }
        }
    };
    auto writeout = [&](int c) {
        const float* YOUT = YOUT0 + (c & 1) * 2048; const float* BONc = BONL + (c % 3) * 32;
        const int tid3 = tid - 384;
        for (int e = tid3; e < 512; e += 128) { const int i = e >> 4, c4 = (e & 15) * 4;
            const int step = c * 32 + i, t = d ? T - 1 - step : step;
            const float4 y4 = *(const float4*)(YOUT + i * 64 + c4);
            uint2 o; o.x = cvt_pk_bf16(y4.x, y4.y); o.y = cvt_pk_bf16(y4.z, y4.w);
            *(uint2*)(YA + (size_t)(g0 + t) * 512 + 64 * h + c4) = o; }
        if (tid3 < 32) { const int st2 = c * 32 + tid3, t2 = d ? T - 1 - st2 : st2; BON[(size_t)(g0 + t2) * 8 + h] = BONc[tid3]; }
    };

    __syncthreads();
    A_load(0);
    prep(0);
    S4(0);
    if (wave == 4 || wave == 5) S5(0);
    __syncthreads();
    for (int c = 0; c < nmc; ++c) {
        const bool more = (c + 1) < nmc;
        if (more) { prep(c + 1); S4(c + 1); }
        if (wave < 4) S6(c);
        else if (wave < 6) { if (more) S5(c + 1); }
        else if (c > 0) writeout(c - 1);
        __syncthreads();
    }
    if (wave >= 6) writeout(nmc - 1);
    if (wave < 4 && !grid) { float* st = p.out + OUT_SA + ((size_t)(bidx * 2 + d) * 8 + h) * 4096 + (16 * wave + lr) * 64;
#pragma unroll
        for (int kt = 0; kt < 4; ++kt) *(float4*)(st + 16 * kt + 4 * lq) = make_float4(ST[kt][0], ST[kt][1], ST[kt][2], ST[kt][3]); }
    __syncthreads();
}

__device__ __forceinline__ void hgrn_item(const Params& p, unsigned char* smem, int seq, int d, int h, int vh) {
    const int tid = otid(), lane = tid & 63, wave = tid >> 6;
    const bool grid = seq >= 16; const int T = grid ? 2048 : 256; const int g0 = grid ? NPTOK + (seq - 16) * 2048 : seq * 256; const int bidx = grid ? seq - 16 : seq;
    bf16_t* QT = (bf16_t*)(smem + 0);
    bf16_t* KT = (bf16_t*)(smem + 17408);
    bf16_t* ST = (bf16_t*)(smem + 34816);
    bf16_t* KH = (bf16_t*)(smem + 52224);
    bf16_t* AM = (bf16_t*)(smem + 70656);
    bf16_t* VT = (bf16_t*)(smem + 79872);
    float* GC = (float*)(smem + 89088);
    float* GSUM = (float*)(smem + 89600);
    const int nch = T / 64;
    const int lr = lane & 15, lq = lane >> 4;
    bf16_t* OB = p.pa + (size_t)NTOK * 1024 + (size_t)d * NTOK * 512;
#ifdef SKIP_HGRN
    for (int e = tid; e < T * 64; e += 512) OB[(size_t)(g0 + (e >> 6)) * 512 + 128 * h + 64 * vh + (e & 63)] = 0;
    if (!grid) for (int e = tid; e < 8192; e += 512) p.out[OUT_SB + ((size_t)((bidx * 2 + d) * 4 + h) * 128 + (e >> 6)) * 128 + 64 * vh + (e & 63)] = 0.f;
    return;
#endif

    f32x4 sacc[4];
#pragma unroll
    for (int x = 0; x < 4; ++x) sacc[x] = (f32x4){0.f, 0.f, 0.f, 0.f};
    if (grid) {
#pragma unroll
        for (int x = 0; x < 4; ++x) { const int id = 4 * wave + x, tv = id >> 3, tk = id & 7;
#pragma unroll
            for (int j = 0; j < 4; ++j) { const int v = tv * 16 + lq * 4 + j, k = tk * 16 + lr;
                sacc[x][j] = p.state_hgrn[((size_t)((bidx * 2 + d) * 4 + h) * 128 + k) * 128 + 64 * vh + v]; } } }
#pragma unroll
    for (int x = 0; x < 4; ++x) { const int id = 4 * wave + x, tv = id >> 3, tk = id & 7;
#pragma unroll
        for (int j = 0; j < 4; ++j) { const int v = tv * 16 + lq * 4 + j, k = tk * 16 + lr; ST[v * 136 + k] = f2bf(sacc[x][j]); } }
    const int kch = 16 * wave + (lane & 15), qd = lane >> 4;

    bf16_t rf[16], rq[16]; u32x4 rv = {0u, 0u, 0u, 0u};
    auto load_raw = [&](int c) {
#pragma unroll
        for (int ii = 0; ii < 16; ++ii) { const int step = c * 64 + 16 * qd + ii, t = d ? T - 1 - step : step; const bf16_t* row = p.pb + (size_t)(g0 + t) * 2560;
            rf[ii] = row[1024 + 512 * d + 128 * h + kch]; rq[ii] = row[128 * h + kch]; }
        { const int s = tid >> 3, v8 = (tid & 7) * 8; const int step = c * 64 + s, t = d ? T - 1 - step : step;
          rv = *(const u32x4*)(p.pb + (size_t)(g0 + t) * 2560 + 512 + 128 * h + 64 * vh + v8); }
    };
    load_raw(0);
    for (int c = 0; c < nch; ++c) {
        float G[16], qv[16], kv[16]; float run = 0.f;
#pragma unroll
        for (int ii = 0; ii < 16; ++ii) {
            const float g = bf2f(rf[ii]);
            run += g; G[ii] = run; qv[ii] = bf2f(rq[ii]); kv[ii] = 1.f - __expf(g); }
        { const int s = tid >> 3, v8 = (tid & 7) * 8; const u32x4 w = rv;
          VT[(v8 + 0) * 72 + s] = (bf16_t)(w.x & 0xffffu); VT[(v8 + 1) * 72 + s] = (bf16_t)(w.x >> 16); VT[(v8 + 2) * 72 + s] = (bf16_t)(w.y & 0xffffu); VT[(v8 + 3) * 72 + s] = (bf16_t)(w.y >> 16);
          VT[(v8 + 4) * 72 + s] = (bf16_t)(w.z & 0xffffu); VT[(v8 + 5) * 72 + s] = (bf16_t)(w.z >> 16); VT[(v8 + 6) * 72 + s] = (bf16_t)(w.w & 0xffffu); VT[(v8 + 7) * 72 + s] = (bf16_t)(w.w >> 16); }
        if (c + 1 < nch) load_raw(c + 1);
        const float t1 = __shfl_up(run, 16); const float s1 = run + (qd >= 1 ? t1 : 0.f);
        const float t2 = __shfl_up(s1, 32); const float s2 = s1 + (qd >= 2 ? t2 : 0.f);
        const float off = s2 - run, tot = __shfl(s2, 48 + (lane & 15));
        const float etot = __expf(tot);
        float khv[16];
#pragma unroll
        for (int ii = 0; ii < 16; ++ii) { const int i = 16 * qd + ii; const float Gi = G[ii] + off;
            const float eg = __expf(Gi), ieg = __builtin_amdgcn_rcpf(eg), kie = kv[ii] * ieg;
            QT[i * 136 + kch] = f2bf(qv[ii] * eg); KT[i * 136 + kch] = f2bf(kie); khv[ii] = kie * etot; }
        { u32x4 o0, o1;
          o0.x = cvt_pk_bf16(khv[0], khv[1]); o0.y = cvt_pk_bf16(khv[2], khv[3]); o0.z = cvt_pk_bf16(khv[4], khv[5]); o0.w = cvt_pk_bf16(khv[6], khv[7]);
          o1.x = cvt_pk_bf16(khv[8], khv[9]); o1.y = cvt_pk_bf16(khv[10], khv[11]); o1.z = cvt_pk_bf16(khv[12], khv[13]); o1.w = cvt_pk_bf16(khv[14], khv[15]);
          *(u32x4*)(KH + kch * 72 + 16 * qd) = o0; *(u32x4*)(KH + kch * 72 + 16 * qd + 8) = o1; }
        if (qd == 0) GC[kch] = etot;
        __syncthreads();
        f32x4 oacc[2];
#pragma unroll
        for (int x = 0; x < 2; ++x) { const int id = 2 * wave + x, tm = id >> 2, tn = id & 3;
            f32x4 a = {0.f, 0.f, 0.f, 0.f}, o = {0.f, 0.f, 0.f, 0.f};
#pragma unroll
            for (int q = 0; q < 4; ++q) { const bf16x8 A = *(const bf16x8*)(QT + (tm * 16 + lr) * 136 + q * 32 + lq * 8);
                const bf16x8 Bk = *(const bf16x8*)(KT + (tn * 16 + lr) * 136 + q * 32 + lq * 8); const bf16x8 Bs = *(const bf16x8*)(ST + (tn * 16 + lr) * 136 + q * 32 + lq * 8);
                a = __builtin_amdgcn_mfma_f32_16x16x32_bf16(A, Bk, a, 0, 0, 0); o = __builtin_amdgcn_mfma_f32_16x16x32_bf16(A, Bs, o, 0, 0, 0); }
#pragma unroll
            for (int j = 0; j < 4; ++j) { const int trow = tm * 16 + lq * 4 + j, scol = tn * 16 + lr; AM[trow * 72 + scol] = f2bf(scol <= trow ? a[j] : 0.f); }
            oacc[x] = o; }
        __syncthreads();
#pragma unroll
        for (int x = 0; x < 2; ++x) { const int id = 2 * wave + x, tm = id >> 2, tn = id & 3;
#pragma unroll
            for (int q = 0; q < 2; ++q) { const bf16x8 A = *(const bf16x8*)(AM + (tm * 16 + lr) * 72 + q * 32 + lq * 8); const bf16x8 B = *(const bf16x8*)(VT + (tn * 16 + lr) * 72 + q * 32 + lq * 8);
                oacc[x] = __builtin_amdgcn_mfma_f32_16x16x32_bf16(A, B, oacc[x], 0, 0, 0); }
#pragma unroll
            for (int j = 0; j < 4; ++j) { const int i = tm * 16 + lq * 4 + j; const int step = c * 64 + i, t = d ? T - 1 - step : step;
                OB[(size_t)(g0 + t) * 512 + 128 * h + 64 * vh + tn * 16 + lr] = f2bf(oacc[x][j]); } }
#pragma unroll
        for (int x = 0; x < 4; ++x) { const int id = 4 * wave + x, tv = id >> 3, tk = id & 7; const float gc = GC[tk * 16 + lr];
            sacc[x] = sacc[x] * gc;
#pragma unroll
            for (int q = 0; q < 2; ++q) { const bf16x8 A = *(const bf16x8*)(VT + (tv * 16 + lr) * 72 + q * 32 + lq * 8); const bf16x8 B = *(const bf16x8*)(KH + (tk * 16 + lr) * 72 + q * 32 + lq * 8);
                sacc[x] = __builtin_amdgcn_mfma_f32_16x16x32_bf16(A, B, sacc[x], 0, 0, 0); }
#pragma unroll
            for (int j = 0; j < 4; ++j) ST[(tv * 16 + lq * 4 + j) * 136 + tk * 16 + lr] = f2bf(sacc[x][j]); }
        __syncthreads();
    }
    if (!grid) {
#pragma unroll
        for (int x = 0; x < 4; ++x) { const int id = 4 * wave + x, tv = id >> 3, tk = id & 7;
#pragma unroll
            for (int j = 0; j < 4; ++j) { const int v = tv * 16 + lq * 4 + j, k = tk * 16 + lr;
                p.out[OUT_SB + ((size_t)((bidx * 2 + d) * 4 + h) * 128 + k) * 128 + 64 * vh + v] = sacc[x][j]; } }
    }
    __syncthreads();
}

__device__ __forceinline__ void phase4(const Params& p, unsigned char* smem, int mode = 0) {
    const int G = gridDim.x, b = blockIdx.x;
    const bool fast = (G == 256);
    const int n_it = fast ? (b < 128 ? 1 : 5) : (768 - b + G - 1) / G;
    for (int n = 0; n < n_it; ++n) {
        const int it = fast ? (n == 0 ? b : 256 + (b - 128) + 128 * (n - 1)) : (b + n * G);
        if ((mode == 1 && it >= 128) || (mode == 2 && it < 128) || (mode == 3 && !(it >= 128 && it < 256))) continue;
        if (it < 128) rwkv_item(p, smem, 16 + (it >> 4), (it >> 3) & 1, it & 7);
        else if (it < 256) { const int j = it - 128; hgrn_item(p, smem, 16 + (j >> 4), (j >> 3) & 1, (j >> 1) & 3, j & 1); }
        else if (it < 512) { const int q = it - 256; rwkv_item(p, smem, q >> 4, (q >> 3) & 1, q & 7); }
        else { const int q2 = it - 512; hgrn_item(p, smem, q2 >> 4, (q2 >> 3) & 1, (q2 >> 1) & 3, q2 & 1); }
    }
}

__device__ __forceinline__ void phase5(const Params& p) {
    const int tid = otid(), lane = tid & 63, wave = tid >> 6;
    const int gw = blockIdx.x * 8 + wave, NGW = gridDim.x * 8;
    const bf16_t* YA0 = p.pa; const bf16_t* YA1 = YA0 + (size_t)NTOK * 512;
    const bf16_t* OB0 = YA0 + (size_t)NTOK * 1024; const bf16_t* OB1 = OB0 + (size_t)NTOK * 512;
    bf16_t* mix = p.xm;
    const int c8 = 8 * lane;
    float lw[8], lb8[8], og[8];
    ld8f(p.lnx_w + c8, lw); ld8f(p.lnx_b + c8, lb8); ld8f(p.onorm_g + c8, og);
    for (int tok = gw; tok < NTOK; tok += NGW) {
        const u32x4 ya0 = *(const u32x4*)(YA0 + (size_t)tok * 512 + c8), ya1 = *(const u32x4*)(YA1 + (size_t)tok * 512 + c8);
        const u32x4 ob0 = *(const u32x4*)(OB0 + (size_t)tok * 512 + c8), ob1 = *(const u32x4*)(OB1 + (size_t)tok * 512 + c8);
        const u32x4 v_c = *(const u32x4*)((const bf16_t*)p.out + (size_t)tok * 1792 + 1024 + c8), z_c = *(const u32x4*)(p.zs + (size_t)tok * 512 + c8);
        const u32x4 zb4 = *(const u32x4*)(p.pb + (size_t)tok * 2560 + 2048 + c8);
        const int hA = lane >> 3;
        const float bonus = p.bon[(size_t)tok * 8 + hA] + p.bon[(size_t)NTOK * 8 + (size_t)tok * 8 + hA];
        float y[8], tmp[8], vv[8], zz[8];
        unpack8(ya0, y); unpack8(ya1, tmp);
        float s = 0.f;
#pragma unroll
        for (int j = 0; j < 8; ++j) { y[j] += tmp[j]; s += y[j]; }
        const float mean = red8(s) * (1.f / 64.f);
        float q = 0.f;
#pragma unroll
        for (int j = 0; j < 8; ++j) { y[j] -= mean; q += y[j] * y[j]; }
        const float rstd = rsqrtf(red8(q) * (1.f / 64.f) + 64e-5f);
        unpack8(v_c, vv); unpack8(z_c, zz);
        float o[8];
#pragma unroll
        for (int j = 0; j < 8; ++j) o[j] = (y[j] * rstd * lw[j] + lb8[j] + bonus * vv[j]) * zz[j];
        { u32x4 w; w.x = cvt_pk_bf16(o[0], o[1]); w.y = cvt_pk_bf16(o[2], o[3]); w.z = cvt_pk_bf16(o[4], o[5]); w.w = cvt_pk_bf16(o[6], o[7]); *(u32x4*)(mix + (size_t)tok * 1024 + c8) = w; }
        unpack8(ob0, y); unpack8(ob1, tmp); unpack8(zb4, zz);
        float ss = 0.f;
#pragma unroll
        for (int j = 0; j < 8; ++j) { y[j] += tmp[j]; ss += y[j] * y[j]; }
        const float rs = rsqrtf(red16(ss) * (1.f / 128.f) + 1e-6f);
#pragma unroll
        for (int j = 0; j < 8; ++j) o[j] = y[j] * rs * og[j] * (zz[j] * sigmoidf_(zz[j]));
        { u32x4 w; w.x = cvt_pk_bf16(o[0], o[1]); w.y = cvt_pk_bf16(o[2], o[3]); w.z = cvt_pk_bf16(o[4], o[5]); w.w = cvt_pk_bf16(o[6], o[7]); *(u32x4*)(mix + (size_t)tok * 1024 + 512 + c8) = w; }
    }
}

__device__ __forceinline__ void phase7(const Params& p) {
    const int tid = otid(), lane = tid & 63, wave = tid >> 6;
    const int gw = blockIdx.x * 8 + wave, NGW = gridDim.x * 8;
    const bool split = (gridDim.x == 256);
    float ga[8], gb[8]; ld8f(p.final_g + 8 * lane, ga); ld8f(p.final_g + 512 + 8 * lane, gb);
    for (int tok = gw; tok < NTOK; tok += 2 * NGW) {
        const bool two = (tok + NGW) < NTOK; const int tokb = two ? tok + NGW : tok;
        const bf16_t* ha = p.pb + (size_t)tok * 1024; const bf16_t* hb = p.pb + (size_t)tokb * 1024;
        const u32x4 a0 = *(const u32x4*)(ha + 8 * lane), a1 = *(const u32x4*)(ha + 512 + 8 * lane), b0 = *(const u32x4*)(hb + 8 * lane), b1 = *(const u32x4*)(hb + 512 + 8 * lane);
        float xa0[8], xa1[8], xb0[8], xb1[8]; unpack8(a0, xa0); unpack8(a1, xa1); unpack8(b0, xb0); unpack8(b1, xb1);
        if (split) {
            if (tok >= 16384) { const bf16_t* q = p.pa + (size_t)(tok - 16384) * 1024; float t0[8], t1[8]; unpack8(*(const u32x4*)(q + 8 * lane), t0); unpack8(*(const u32x4*)(q + 512 + 8 * lane), t1);
#pragma unroll
                for (int j = 0; j < 8; ++j) { xa0[j] += t0[j]; xa1[j] += t1[j]; } }
            if (tokb >= 16384) { const bf16_t* q = p.pa + (size_t)(tokb - 16384) * 1024; float t0[8], t1[8]; unpack8(*(const u32x4*)(q + 8 * lane), t0); unpack8(*(const u32x4*)(q + 512 + 8 * lane), t1);
#pragma unroll
                for (int j = 0; j < 8; ++j) { xb0[j] += t0[j]; xb1[j] += t1[j]; } }
        }
        float sa = 0.f, sb = 0.f;
#pragma unroll
        for (int j = 0; j < 8; ++j) { sa += xa0[j] * xa0[j] + xa1[j] * xa1[j]; sb += xb0[j] * xb0[j] + xb1[j] * xb1[j]; }
        sa = wave_sum_fast(sa); sb = wave_sum_fast(sb);
        const float ra = rsqrtf(sa * (1.f / 1024.f) + 1e-6f), rb = rsqrtf(sb * (1.f / 1024.f) + 1e-6f);
        float* ya = p.out + (size_t)tok * 1024; float* yb = p.out + (size_t)tokb * 1024;
        *(float4*)(ya + 8 * lane) = make_float4(xa0[0] * ra * ga[0], xa0[1] * ra * ga[1], xa0[2] * ra * ga[2], xa0[3] * ra * ga[3]);
        *(float4*)(ya + 8 * lane + 4) = make_float4(xa0[4] * ra * ga[4], xa0[5] * ra * ga[5], xa0[6] * ra * ga[6], xa0[7] * ra * ga[7]);
        *(float4*)(ya + 512 + 8 * lane) = make_float4(xa1[0] * ra * gb[0], xa1[1] * ra * gb[1], xa1[2] * ra * gb[2], xa1[3] * ra * gb[3]);
        *(float4*)(ya + 512 + 8 * lane + 4) = make_float4(xa1[4] * ra * gb[4], xa1[5] * ra * gb[5], xa1[6] * ra * gb[6], xa1[7] * ra * gb[7]);
        if (two) {
            *(float4*)(yb + 8 * lane) = make_float4(xb0[0] * rb * ga[0], xb0[1] * rb * ga[1], xb0[2] * rb * ga[2], xb0[3] * rb * ga[3]);
            *(float4*)(yb + 8 * lane + 4) = make_float4(xb0[4] * rb * ga[4], xb0[5] * rb * ga[5], xb0[6] * rb * ga[6], xb0[7] * rb * ga[7]);
            *(float4*)(yb + 512 + 8 * lane) = make_float4(xb1[0] * rb * gb[0], xb1[1] * rb * gb[1], xb1[2] * rb * gb[2], xb1[3] * rb * gb[3]);
            *(float4*)(yb + 512 + 8 * lane + 4) = make_float4(xb1[4] * rb * gb[4], xb1[5] * rb * gb[5], xb1[6] * rb * gb[6], xb1[7] * rb * gb[7]);
        }
    }
}

#define XB_TMO      128
#define XB_XCNT(j)  (256  + 64 * (j))
#define XB_XSUB(j)  (1280 + 64 * (j))
#define XB_XGEN(j)  (2304 + 64 * (j))
#define XB_TOP      3328
#define XB_TOPGEN   3392
#define XCD_BAR_WORDS 3456
#define XB_SPIN_CAP (1u << 18)
#define XLAS __attribute__((address_space(3)))

__device__ __forceinline__ unsigned xb_ld(unsigned* p)              { return __hip_atomic_load(p, __ATOMIC_RELAXED, __HIP_MEMORY_SCOPE_AGENT); }
__device__ __forceinline__ unsigned xb_add(unsigned* p, unsigned v) { return __hip_atomic_fetch_add(p, v, __ATOMIC_RELAXED, __HIP_MEMORY_SCOPE_AGENT); }
__device__ __forceinline__ unsigned xb_xcc_id() { return (unsigned)__builtin_amdgcn_s_getreg((3 << 11) | 20) & 0xFu; }
#define XB_SPIN(cond, bar) do { unsigned _sp = 0; while (cond) { __builtin_amdgcn_s_sleep(1); \
    if ((++_sp & 255u) == 0u) { if (xb_ld(&(bar)[XB_TMO])) break; if (_sp > XB_SPIN_CAP) { atomicAdd(&(bar)[XB_TMO], 1u); break; } } } } while (0)

struct XcdBarrier {
    unsigned* bar; unsigned x;
    volatile XLAS unsigned* st;
};

__device__ __forceinline__ XcdBarrier xcd_barrier_post(unsigned* bar, volatile XLAS unsigned* st) {
    XcdBarrier b; b.bar = bar; b.x = xb_xcc_id(); b.st = st;
    if (threadIdx.x == 0) (void)xb_add(&bar[XB_XCNT(b.x)], 1u);
    return b;
}
__device__ __forceinline__ void xcd_barrier_complete(unsigned* bar, unsigned x, unsigned& nloc, unsigned& nx) {
    const unsigned G = gridDim.x * gridDim.y * gridDim.z;
    unsigned sum, cnt, mine, sp = 0u;
    for (;;) {
        sum = 0u; cnt = 0u; mine = 0u;
#pragma unroll
        for (unsigned j = 0; j < 16; ++j) { const unsigned c = xb_ld(&bar[XB_XCNT(j)]); sum += c; cnt += (c > 0u) ? 1u : 0u; mine = (j == x) ? c : mine; }
        if (sum == G) break;
        __builtin_amdgcn_s_sleep(1);
        if ((++sp & 255u) == 0u) { if (xb_ld(&bar[XB_TMO])) break; if (sp > XB_SPIN_CAP) { atomicAdd(&bar[XB_TMO], 1u); break; } }
    }
    nloc = mine > 0u ? mine : 1u; nx = cnt > 0u ? cnt : 1u;
}

__device__ __forceinline__ void xcd_barrier(const XcdBarrier& b) {
    asm volatile("s_waitcnt vmcnt(0)" ::: "memory");
    __syncthreads();
    if (threadIdx.x == 0) {
        unsigned* bar = b.bar;
        __builtin_amdgcn_s_waitcnt(0);
        unsigned nloc = b.st[0], nx = b.st[1];
        if (nloc == 0u) { xcd_barrier_complete(bar, b.x, nloc, nx); b.st[0] = nloc; b.st[1] = nx; }
        const unsigned old = xb_add(&bar[XB_XSUB(b.x)], 1u);
        const unsigned gen = old / nloc;
        if (old + 1u == (gen + 1u) * nloc) {
            __builtin_amdgcn_fence(__ATOMIC_RELEASE, "agent");
            asm volatile("s_waitcnt vmcnt(0)" ::: "memory");
            const unsigned og = xb_add(&bar[XB_TOP], 1u);
            const unsigned tg = og / nx;
            if (og + 1u == (tg + 1u) * nx) xb_add(&bar[XB_TOPGEN], 1u);
            else XB_SPIN(xb_ld(&bar[XB_TOPGEN]) == tg, bar);
            __builtin_amdgcn_fence(__ATOMIC_ACQUIRE, "agent");
            xb_add(&bar[XB_XGEN(b.x)], 1u);
            asm volatile("s_waitcnt vmcnt(0)" ::: "memory");
        } else {
            XB_SPIN(xb_ld(&bar[XB_XGEN(b.x)]) == gen, bar);
            __builtin_amdgcn_fence(__ATOMIC_ACQUIRE, "agent");
            asm volatile("s_waitcnt vmcnt(0)" ::: "memory");
        }
    }
    __syncthreads();
}


__device__ __forceinline__ void gsync(cg::grid_group& g) {
    asm volatile("s_waitcnt vmcnt(0) lgkmcnt(0)" ::: "memory");
    g.sync();
    if (threadIdx.x < 64) { __builtin_amdgcn_fence(__ATOMIC_ACQUIRE, "agent"); asm volatile("s_waitcnt vmcnt(0)" ::: "memory"); }
    __syncthreads();
}
__global__ __launch_bounds__(512, 2) void fwd_megakernel(Params p) {
    extern __shared__ __attribute__((aligned(16))) unsigned char shm[];
    cg::grid_group grid = cg::this_grid();
    volatile XLAS unsigned* xst = (volatile XLAS unsigned*)(shm + LDS_BYTES - 16);
    if (threadIdx.x == 0) { xst[0] = 0u; xst[1] = 0u; }
    __syncthreads();
    const XcdBarrier xb = xcd_barrier_post(p.bar, xst);
    bool dup_done = false; (void)dup_done;
    for (int ph = p.ph_lo; ph < p.ph_hi; ++ph) {
        if (ph == 0) phase0(p, shm);
        else if (ph == 1) phase1(p, shm);
        else if (ph == 2) { pg8::StaticOrder S; S.init(NTOK, 4864, (int)gridDim.x, (int)blockIdx.x); pg8::Gemm g{p.xm, p.wt_in, NTOK, 4864, 1024, 1024}; pg8::EpiP E{p.pa, p.pb, p.lb_logits};
            pg8::gemm_phase<pg8::EpiP, pg8::StaticOrder>((PG8_LAS unsigned char*)shm, g, S, E); }
        else if (ph == 3) phase3(p);
#ifdef P4MODE
        else if (ph == 4) phase4(p, shm, dup_done ? P4MODE : 0);
#else
        else if (ph == 4) phase4(p, shm);
#endif
        else if (ph == 5) phase5(p);
        else if (ph == 6) {
            if (gridDim.x == 256) {
                const int b = blockIdx.x;
                { pg8::OrderOne S{8 * (b & 7) + (b >> 5), (b >> 3) & 3, true}; pg8::Gemm g{p.xm, p.wt_out, NTOK, 1024, 1024, 1024}; pg8::EpiH E{p.x_prompt, p.x_sample, p.gate, p.pb, p.pa, 0};
                  pg8::gemm_phase<pg8::EpiH, pg8::OrderOne>((PG8_LAS unsigned char*)shm, g, S, E); }
                { const int u2 = b >> 1, half = b & 1; pg8::OrderOne S{64 + (u2 >> 2), u2 & 3, b < 128};
                  pg8::Gemm g{p.xm + 512 * half, p.wt_out + 512 * half, NTOK, 1024, 512, 1024}; pg8::EpiH E{p.x_prompt, p.x_sample, p.gate, p.pb, p.pa, half};
                  pg8::gemm_phase<pg8::EpiH, pg8::OrderOne>((PG8_LAS unsigned char*)shm, g, S, E); }
            } else { pg8::StaticOrder S; S.init(NTOK, 1024, (int)gridDim.x, (int)blockIdx.x); pg8::Gemm g{p.xm, p.wt_out, NTOK, 1024, 1024, 1024}; pg8::EpiH E{p.x_prompt, p.x_sample, p.gate, p.pb, p.pa, 0};
                pg8::gemm_phase<pg8::EpiH, pg8::StaticOrder>((PG8_LAS unsigned char*)shm, g, S, E); }
        }
        else phase7(p);
        if (ph + 1 < p.ph_hi) { if (p.ph_lo < 0) gsync(grid); else xcd_barrier(xb); }
#ifdef DUPPH
        if (ph == DUPPH && !dup_done) { dup_done = true; --ph; }
#endif
    }
}

#ifndef NLAUNCH
#define NLAUNCH 1
#endif
extern "C" void kernel_launch(void* const* d_in, const int* in_sizes, int n_in, void* d_out, int out_size, void* d_ws, size_t ws_size, hipStream_t stream) {
    static int grid_blocks = 0;
    if (grid_blocks == 0) {
        if (n_in != 25 || ws_size < WS_END) { fprintf(stderr, "kernel_launch: unexpected n_in %d / ws %zu (need %zu)\n", n_in, ws_size, (size_t)WS_END); grid_blocks = -1; return; }
        int dev = 0, cus = 0, per_cu = 0;
        hipGetDevice(&dev);
        hipDeviceGetAttribute(&cus, hipDeviceAttributeMultiprocessorCount, dev);
        hipFuncSetAttribute((const void*)fwd_megakernel, hipFuncAttributeMaxDynamicSharedMemorySize, LDS_BYTES);
        hipOccupancyMaxActiveBlocksPerMultiprocessor(&per_cu, (const void*)fwd_megakernel, 512, LDS_BYTES);
        if (per_cu < 1) { fprintf(stderr, "kernel_launch: occupancy query says %d blocks per CU\n", per_cu); grid_blocks = -1; return; }
        grid_blocks = cus;
    }
    if (grid_blocks < 0) return;
    Params p{};
    const float* const* in = (const float* const*)d_in;
    p.x_prompt = in[0]; p.x_sample = in[1]; p.state_rwkv = in[2]; p.state_hgrn = in[3]; p.c = in[4]; p.c_ctx = in[5]; p.norm_g = in[6]; p.w_ada = in[7]; p.b_ada = in[8]; p.w_in = in[9];
    p.mu_h = in[10]; p.mu_v = in[11]; p.w0 = in[12]; p.w2 = in[13]; p.a0 = in[14]; p.a2 = in[15]; p.k_k = in[16]; p.k_a = in[17]; p.r_k = in[18]; p.lnx_w = in[19]; p.lnx_b = in[20];
    p.lb_logits = in[21]; p.onorm_g = in[22]; p.w_out = in[23]; p.final_g = in[24];
    p.out = (float*)d_out;
    unsigned char* ws = (unsigned char*)d_ws;
    p.modp = (float*)(ws + WS_MODP); p.gate = (float*)(ws + WS_GATE); p.bon = (float*)(ws + WS_BON); p.wt_in = (bf16_t*)(ws + WS_WTIN); p.wt_out = (bf16_t*)(ws + WS_WTOUT);
    p.xm = (bf16_t*)(ws + WS_XM); p.pa = (bf16_t*)(ws + WS_PA); p.pb = (bf16_t*)(ws + WS_PB); p.zs = (bf16_t*)(ws + WS_WTIN);
    p.bar = (unsigned*)(ws + WS_BAR);
    hipMemsetAsync(ws + WS_BAR, 0, XCD_BAR_WORDS * sizeof(unsigned), stream);
#if NLAUNCH == 1
    p.ph_lo = 0; p.ph_hi = 8;
    void* args[] = {&p};
    hipError_t e = hipLaunchCooperativeKernel((const void*)fwd_megakernel, dim3(grid_blocks), dim3(512), args, LDS_BYTES, stream);
    if (e != hipSuccess) fprintf(stderr, "cooperative launch failed: %s (grid %d)\n", hipGetErrorString(e), grid_blocks);
#else
    for (int ph = 0; ph < 8; ++ph) { p.ph_lo = ph; p.ph_hi = ph + 1; hipLaunchKernelGGL(fwd_megakernel, dim3(grid_blocks), dim3(512), LDS_BYTES, stream, p); }
#endif
}
```
